# Optimizing an MI355X kernel written in HIP

```python
import math
import jax, jax.numpy as jnp
from jax import lax
import numpy as np

D_MODEL = 2048
BATCH = 1
SEQ = 16384
DEPTH = 1
DEC_BATCH = 32
DEC_SEQ = 64
PAST_LEN = 1024

CHUNK = 64
HD_A = 128
H_A = D_MODEL // HD_A
D_A = H_A * HD_A
H_I = 16
D_IDX = 64
TOPK_MAX = 256
Q_BLOCK = 128
NUM_BUCKETS = 32
MAX_DISTANCE = 128
DK_B = 128
DV_B = 128
H_B = D_MODEL // DV_B
D_B = H_B * DV_B
CONVB_DIM = 2 * H_B * DK_B + D_B
CONVB_WIDTH = 4
D_FF = 5632
FFN_CONV_WIDTH = 3
EPS = 1e-6
IN_SPLITS = (D_A, D_A, D_A, H_I * D_IDX, D_IDX, H_I, CONVB_DIM, H_B, H_B, D_B, D_MODEL, D_MODEL)
D_IN = 3 * D_A + H_I * D_IDX + D_IDX + H_I + CONVB_DIM + 2 * H_B + D_B + 2 * D_MODEL

kernel_name = 'hybrid_dsa_gdn_convffn_stream_step'


def rmsnorm(x, g):
    xf = x.astype(jnp.float32)
    y = xf * lax.rsqrt(jnp.mean(xf * xf, axis=-1, keepdims=True) + EPS)
    return y.astype(x.dtype) * g


def l2norm(x):
    xf = x.astype(jnp.float32)
    return (xf * lax.rsqrt(jnp.sum(xf * xf, axis=-1, keepdims=True) + EPS)).astype(x.dtype)


def causal_dwconv(x, state, w):
    width = w.shape[0]
    L = x.shape[1]
    xp = jnp.concatenate([state.astype(x.dtype), x], axis=1)
    y = sum(xp[:, i:i + L] * w[i] for i in range(width))
    return y, xp[:, xp.shape[1] - (width - 1):]


def t5_bucket(rel):
    half = NUM_BUCKETS // 2
    max_exact = half // 2
    ret = jnp.where(rel > 0, half, 0)
    n = jnp.abs(rel)
    nf = jnp.maximum(n, 1).astype(jnp.float32)
    large = max_exact + (jnp.log(nf / max_exact) / math.log(MAX_DISTANCE / max_exact)
                         * (half - max_exact)).astype(jnp.int32)
    large = jnp.minimum(large, half - 1)
    return ret + jnp.where(n < max_exact, n, large)


def sparse_attention(q, k, v, qi, ki, wi, q_pos, k_pos, rel_bias):
    B, Q, H, dh = q.shape
    L = k.shape[1]
    n_sel = min(TOPK_MAX, L // 4)
    qb = min(Q_BLOCK, Q)
    limit = (q_pos // CHUNK + 1) * CHUNK

    def block(i):
        s = i * qb
        q_b = lax.dynamic_slice_in_dim(q, s, qb, axis=1)
        qi_b = lax.dynamic_slice_in_dim(qi, s, qb, axis=1)
        wi_b = lax.dynamic_slice_in_dim(wi, s, qb, axis=1)
        pos_b = lax.dynamic_slice_in_dim(q_pos, s, qb)
        lim_b = lax.dynamic_slice_in_dim(limit, s, qb)
        dots = jnp.einsum('bqhd,bsd->bqhs', qi_b, ki).astype(jnp.float32)
        score = jnp.einsum('bqhs,bqh->bqs', jax.nn.relu(dots), wi_b.astype(jnp.float32))
        score = jnp.where(k_pos[None, None, :] < lim_b[None, :, None], score, -jnp.inf)
        _, sel = lax.top_k(score, n_sel)
        k_sel = jax.vmap(lambda kk, ii: kk[ii])(k, sel)
        v_sel = jax.vmap(lambda vv, ii: vv[ii])(v, sel)
        pos_sel = k_pos[sel]
        logits = jnp.einsum('bqhd,bqkhd->bqhk', q_b, k_sel).astype(jnp.float32) * (dh ** -0.5)
        bias = jnp.moveaxis(rel_bias[t5_bucket(pos_sel - pos_b[None, :, None])], 3, 2).astype(jnp.float32)
        ok = (pos_sel < lim_b[None, :, None])[:, :, None, :]
        p = jax.nn.softmax(jnp.where(ok, logits + bias, -jnp.inf), axis=-1)
        return jnp.einsum('bqhk,bqkhd->bqhd', p.astype(v.dtype), v_sel)

    out = lax.map(block, jnp.arange(Q // qb))
    return jnp.moveaxis(out, 0, 1).reshape(B, Q, H, dh)


def gated_delta_rule(q, k, v, g, beta, s0):
    B, L, H, dk = q.shape
    dv = v.shape[-1]
    out_dtype = v.dtype
    f32 = jnp.float32
    pad = (-L) % CHUNK
    n = (L + pad) // CHUNK

    def blocks(t):
        t = jnp.pad(t.astype(f32), [(0, 0), (0, pad)] + [(0, 0)] * (t.ndim - 2))
        t = t.reshape((B, n, CHUNK) + t.shape[2:])
        return jnp.moveaxis(t, 3, 2)

    q, k, v, g, beta = blocks(q), blocks(k), blocks(v), blocks(g), blocks(beta)
    gc = jnp.cumsum(g, axis=-1)
    idx = jnp.arange(CHUNK)
    incl = idx[:, None] >= idx[None, :]
    strict = idx[:, None] > idx[None, :]
    decay = jnp.exp(jnp.where(incl, gc[..., :, None] - gc[..., None, :], -jnp.inf))
    kb = k * beta[..., None]
    vb = v * beta[..., None]
    m = jnp.where(strict, jnp.einsum('bnhid,bnhjd->bnhij', kb, k) * decay, 0.0)
    eye = jnp.eye(CHUNK, dtype=f32)
    tinv = lax.linalg.triangular_solve(m + eye, jnp.broadcast_to(eye, m.shape),
                                       left_side=True, lower=True, unit_diagonal=True)
    u = tinv @ vb
    w = tinv @ (kb * jnp.exp(gc)[..., None])
    attn = jnp.where(incl, jnp.einsum('bnhid,bnhjd->bnhij', q, k) * decay, 0.0)
    qg = q * jnp.exp(gc)[..., None]
    kd = k * jnp.exp(gc[..., -1:] - gc)[..., None]
    glast = jnp.exp(gc[..., -1])

    def step(s, xs):
        u_n, w_n, a_n, qg_n, kd_n, gl_n = xs
        v_new = u_n - jnp.einsum('bhck,bhkv->bhcv', w_n, s)
        o = jnp.einsum('bhck,bhkv->bhcv', qg_n, s) + jnp.einsum('bhij,bhjv->bhiv', a_n, v_new)
        s = s * gl_n[..., None, None] + jnp.einsum('bhck,bhcv->bhkv', kd_n, v_new)
        return s, o

    xs = tuple(jnp.moveaxis(t, 1, 0) for t in (u, w, attn, qg, kd, glast))
    s_fin, o = lax.scan(step, s0.astype(f32), xs)
    o = jnp.moveaxis(jnp.moveaxis(o, 0, 1), 2, 3).reshape(B, n * CHUNK, H, dv)[:, :L]
    return o.astype(out_dtype), s_fin.astype(s0.dtype)


def hybrid_layer(x, c, cache_k, cache_v, cache_kidx, st_conv_b, st_delta, st_ffn, rel_bias,
                 w_ada, b_ada, g_norm1, w_in, conv_b_w, a_log, dt_bias, g_delta_norm, w_out,
                 g_norm2, w_ffn_gate, ffn_conv_w, ffn_conv_b, w_ffn_up, w_ffn_down):
    B, T, _ = x.shape
    P = cache_k.shape[1]
    mod = jnp.einsum('bd,de->be', jax.nn.silu(c), w_ada) + b_ada
    sh1, sc1, gt1, sh2, sc2, gt2 = [m[:, None, :] for m in jnp.split(mod, 6, axis=-1)]

    h = rmsnorm(x, g_norm1) * (1 + sc1) + sh1
    proj = jnp.einsum('btd,de->bte', h, w_in)
    offsets = [int(o) for o in np.cumsum(IN_SPLITS)[:-1]]
    qa, ka, va, qi, ki, wi, qkv_b, a_b, b_b, z_b, gate_a, gate_b = jnp.split(proj, offsets, axis=-1)

    qa = qa.reshape(B, T, H_A, HD_A)
    ka = ka.reshape(B, T, H_A, HD_A)
    va = va.reshape(B, T, H_A, HD_A)
    qi = qi.reshape(B, T, H_I, D_IDX)
    wi = wi * ((H_I * D_IDX) ** -0.5)
    k_all = jnp.concatenate([cache_k.astype(ka.dtype), ka], axis=1)
    v_all = jnp.concatenate([cache_v.astype(va.dtype), va], axis=1)
    ki_all = jnp.concatenate([cache_kidx.astype(ki.dtype), ki], axis=1)
    q_pos = P + jnp.arange(T, dtype=jnp.int32)
    k_pos = jnp.arange(P + T, dtype=jnp.int32)
    o_a = sparse_attention(qa, k_all, v_all, qi, ki_all, wi, q_pos, k_pos, rel_bias).reshape(B, T, D_A)

    conv_qkv, new_conv_b = causal_dwconv(qkv_b, st_conv_b, conv_b_w)
    conv_qkv = jax.nn.silu(conv_qkv)
    q_b, k_b, v_b = jnp.split(conv_qkv, [H_B * DK_B, 2 * H_B * DK_B], axis=-1)
    q_b = l2norm(q_b.reshape(B, T, H_B, DK_B)) * (DK_B ** -0.5)
    k_b = l2norm(k_b.reshape(B, T, H_B, DK_B))
    v_b = v_b.reshape(B, T, H_B, DV_B)
    log_decay = -jnp.exp(a_log.astype(jnp.float32)) * jax.nn.softplus(a_b.astype(jnp.float32) + dt_bias.astype(jnp.float32))
    beta = jax.nn.sigmoid(b_b.astype(jnp.float32))
    o_b, new_delta = gated_delta_rule(q_b, k_b, v_b, log_decay, beta, st_delta)
    o_b = (rmsnorm(o_b, g_delta_norm) * jax.nn.silu(z_b.reshape(B, T, H_B, DV_B))).reshape(B, T, D_B)

    mixed = jax.nn.sigmoid(gate_a) * o_a + jax.nn.sigmoid(gate_b) * o_b
    x = x + gt1 * jnp.einsum('btd,de->bte', mixed, w_out)

    h2 = rmsnorm(x, g_norm2) * (1 + sc2) + sh2
    a, new_ffn = causal_dwconv(jnp.einsum('btd,df->btf', h2, w_ffn_gate), st_ffn, ffn_conv_w)
    y = jnp.einsum('btf,fd->btd', jax.nn.silu(a + ffn_conv_b) * jnp.einsum('btd,df->btf', h2, w_ffn_up), w_ffn_down)
    x = x + gt2 * y
    return x, ka, va, ki, new_conv_b, new_delta, new_ffn


def run_group(x, c, cache_k, cache_v, cache_kidx, st_conv_b, st_delta, st_ffn, rel_bias, g_final, layer_weights):
    outs = [[] for _ in range(6)]
    for l in range(DEPTH):
        x, ka, va, ki, cb, sd, sf = hybrid_layer(
            x, c, cache_k[l], cache_v[l], cache_kidx[l], st_conv_b[l], st_delta[l], st_ffn[l], rel_bias,
            *[w[l] for w in layer_weights])
        for lst, val in zip(outs, (ka, va, ki, cb, sd, sf)):
            lst.append(val)
    y = rmsnorm(x, g_final)
    st = [jnp.stack(lst, axis=0) for lst in outs]
    return y, st[0], st[1], st[2], st[3], st[4], st[5]


def setup_inputs(seed: int = 0) -> dict:
    key = jax.random.key(seed)
    ks = jax.random.split(key, 28)

    def nrm(k, shape, s):
        return jax.random.normal(k, shape, jnp.float32) * s

    d = DEPTH
    dt = jnp.exp(jax.random.uniform(ks[15], (d, H_B), minval=math.log(1e-3), maxval=math.log(1e-1)))
    return {
        'x_prompt': nrm(ks[0], (BATCH, SEQ, D_MODEL), 1.0),
        'x_sample': nrm(ks[1], (DEC_BATCH, DEC_SEQ, D_MODEL), 1.0),
        'c_prompt': nrm(ks[2], (BATCH, D_MODEL), 1.0),
        'c_sample': nrm(ks[3], (DEC_BATCH, D_MODEL), 1.0),
        'cache_k': nrm(ks[4], (d, DEC_BATCH, PAST_LEN, H_A, HD_A), 1.0),
        'cache_v': nrm(ks[5], (d, DEC_BATCH, PAST_LEN, H_A, HD_A), 1.0),
        'cache_kidx': nrm(ks[6], (d, DEC_BATCH, PAST_LEN, D_IDX), 1.0),
        'state_conv_b': nrm(ks[7], (d, DEC_BATCH, CONVB_WIDTH - 1, CONVB_DIM), 1.0),
        'state_delta': nrm(ks[8], (d, DEC_BATCH, H_B, DK_B, DV_B), 0.1),
        'state_ffn_conv': nrm(ks[9], (d, DEC_BATCH, FFN_CONV_WIDTH - 1, D_FF), 1.0),
        'rel_bias': nrm(ks[10], (NUM_BUCKETS, H_A), 0.5),
        'g_final': 1.0 + nrm(ks[11], (D_MODEL,), 0.02),
        'w_ada': nrm(ks[12], (d, D_MODEL, 6 * D_MODEL), 0.5 * D_MODEL ** -0.5),
        'b_ada': nrm(ks[13], (d, 6 * D_MODEL), 0.01),
        'g_norm1': 1.0 + nrm(ks[14], (d, D_MODEL), 0.02),
        'w_in': nrm(ks[16], (d, D_MODEL, D_IN), D_MODEL ** -0.5),
        'conv_b_w': nrm(ks[17], (d, CONVB_WIDTH, CONVB_DIM), CONVB_WIDTH ** -0.5),
        'a_log': jnp.log(jax.random.uniform(ks[18], (d, H_B), minval=1.0, maxval=16.0)),
        'dt_bias': dt + jnp.log(-jnp.expm1(-dt)),
        'g_delta_norm': 1.0 + nrm(ks[19], (d, DV_B), 0.02),
        'w_out': nrm(ks[20], (d, D_A, D_MODEL), D_A ** -0.5),
        'g_norm2': 1.0 + nrm(ks[21], (d, D_MODEL), 0.02),
        'w_ffn_gate': nrm(ks[22], (d, D_MODEL, D_FF), D_MODEL ** -0.5),
        'ffn_conv_w': nrm(ks[23], (d, FFN_CONV_WIDTH, D_FF), FFN_CONV_WIDTH ** -0.5),
        'ffn_conv_b': nrm(ks[24], (d, D_FF), 0.01),
        'w_ffn_up': nrm(ks[25], (d, D_MODEL, D_FF), D_MODEL ** -0.5),
        'w_ffn_down': nrm(ks[26], (d, D_FF, D_MODEL), D_FF ** -0.5),
    }


def reference(x_prompt, x_sample, c_prompt, c_sample, cache_k, cache_v, cache_kidx, state_conv_b,
              state_delta, state_ffn_conv, rel_bias, g_final, w_ada, b_ada, g_norm1, w_in, conv_b_w,
              a_log, dt_bias, g_delta_norm, w_out, g_norm2, w_ffn_gate, ffn_conv_w, ffn_conv_b,
              w_ffn_up, w_ffn_down):
    layer_weights = (w_ada, b_ada, g_norm1, w_in, conv_b_w, a_log, dt_bias, g_delta_norm, w_out,
                     g_norm2, w_ffn_gate, ffn_conv_w, ffn_conv_b, w_ffn_up, w_ffn_down)
    bp = x_prompt.shape[0]
    dt = x_prompt.dtype
    y_prompt, k_p, v_p, ki_p, cb_p, sd_p, sf_p = run_group(
        x_prompt, c_prompt,
        jnp.zeros((DEPTH, bp, 0, H_A, HD_A), dt), jnp.zeros((DEPTH, bp, 0, H_A, HD_A), dt),
        jnp.zeros((DEPTH, bp, 0, D_IDX), dt), jnp.zeros((DEPTH, bp, CONVB_WIDTH - 1, CONVB_DIM), dt),
        jnp.zeros((DEPTH, bp, H_B, DK_B, DV_B), dt), jnp.zeros((DEPTH, bp, FFN_CONV_WIDTH - 1, D_FF), dt),
        rel_bias, g_final, layer_weights)
    y_sample, k_s, v_s, ki_s, cb_s, sd_s, sf_s = run_group(
        x_sample, c_sample, cache_k, cache_v, cache_kidx, state_conv_b, state_delta, state_ffn_conv,
        rel_bias, g_final, layer_weights)
    return (y_prompt, y_sample, k_p, v_p, ki_p, cb_p, sd_p, sf_p, k_s, v_s, ki_s, cb_s, sd_s, sf_s)
```

```cpp
#include <hip/hip_runtime.h>
#include <stdint.h>
#include <cstdio>

#define LAS __attribute__((address_space(3)))
typedef unsigned short bf16_t;
typedef short bf16x8 __attribute__((ext_vector_type(8)));
typedef short s16x4 __attribute__((ext_vector_type(4)));
typedef float f32x4 __attribute__((ext_vector_type(4)));
typedef float f32x2 __attribute__((ext_vector_type(2)));
typedef float f32x16 __attribute__((ext_vector_type(16)));
typedef unsigned u32x4 __attribute__((ext_vector_type(4)));
typedef unsigned u32x2 __attribute__((ext_vector_type(2)));

constexpr int DM = 2048, SEQ = 16384, NB = 32, TS = 64, PAST = 1024, LS = PAST + TS;
constexpr int MT = SEQ + NB * TS;
constexpr int NSEQ = 1 + NB;
constexpr int DFF = 5632, CONVB = 6144, DIN = 19568;
constexpr int NPAD = 19712;
constexpr int NUNIT = 288 * 16;
constexpr int UB_W = 0, UB_QG = 16896, UB_A = 33792, UB_KD = 42496, UB_U = 59904, UNITB = 76288, RW = 264, RA = 136;
constexpr size_t O_YP = 0, O_YS = 33554432, O_KP = 37748736, O_VP = 71303168, O_KIP = 104857600, O_CBP = 105906176, O_DP = 105924608, O_FP = 106186752,
                 O_KS = 106198016, O_VS = 110392320, O_KIS = 114586624, O_CBS = 114717696, O_DS = 115307520, O_FS = 123696128, O_END = 124056576;
constexpr size_t WS_CTL = 0, WS_MOD = 65536, WS_WI = WS_MOD + 1622016, WS_AB = WS_WI + 1179648, WS_BB = WS_AB + 1179648, WS_GL = WS_BB + 1179648,
                 WS_KIP = WS_GL + 18432, WS_KIS = WS_KIP + 2097152, WS_MASKP = WS_KIS + 4456448, WS_MASKS = WS_MASKP + 33554432, WS_WOUT = WS_MASKS + 294912,
                 WS_WGU = WS_WOUT + 8388608, WS_WDN = WS_WGU + 46137344, WS_WIN = WS_WDN + 23068672, WS_H = WS_WIN + 80740352, WS_Q = WS_H + 75497472,
                 WS_KP = WS_Q + 75497472, WS_VP = WS_KP + 67108864, WS_QI = WS_VP + 67108864, WS_QKVB = WS_QI + 37748736, WS_Z = WS_QKVB + 226492416,
                 WS_GA = WS_Z + 75497472, WS_GB = WS_GA + 75497472, WS_R2 = WS_GB + 75497472, WS_END = WS_R2 + 44323328;
constexpr size_t WS_OB = WS_QKVB;
constexpr size_t WS_GP = WS_Q, WS_UP = WS_Q + 207618048;
constexpr int R0_UNITS = 1979, R1_UNITS = 2048;
static_assert(WS_UP + 207618048 <= WS_Z, "ffn buffers overlap");
static_assert(WS_END <= 1073741824ull, "workspace budget");

constexpr int NTHREADS = 512;
constexpr int LDS_BYTES = 155648;
constexpr int MISC_OFF = 155648 - 256;

struct Params { const float* in[27]; float* out; unsigned char* ws; int ph_lo, ph_hi; };

__device__ __forceinline__ unsigned cvt_pk_bf16(float lo, float hi) { unsigned r; asm volatile("v_cvt_pk_bf16_f32 %0, %1, %2" : "=v"(r) : "v"(lo), "v"(hi)); return r; }
__device__ __forceinline__ bf16_t f2bf(float f) { return (bf16_t)(cvt_pk_bf16(f, 0.f) & 0xffffu); }
__device__ __forceinline__ float bf2f(bf16_t b) { return __uint_as_float(((unsigned)b) << 16); }
__device__ __forceinline__ float bflo(unsigned w) { return __uint_as_float(w << 16); }
__device__ __forceinline__ float bfhi(unsigned w) { return __uint_as_float(w & 0xffff0000u); }
__device__ __forceinline__ float wave_sum(float v) { v += __shfl_xor(v, 32); v += __shfl_xor(v, 16); v += __shfl_xor(v, 8); v += __shfl_xor(v, 4); v += __shfl_xor(v, 2); v += __shfl_xor(v, 1); return v; }
__device__ __forceinline__ float sigmoidf_(float x) { return 1.0f / (1.0f + __expf(-x)); }
__device__ __forceinline__ float siluf_(float x) { return x / (1.0f + __expf(-x)); }
__device__ __forceinline__ int seq_of_row(int m) { return m < SEQ ? 0 : 1 + ((m - SEQ) >> 6); }
__device__ __forceinline__ int crow(int r, int hi) { return (r & 3) + 8 * (r >> 2) + 4 * hi; }
__device__ __forceinline__ unsigned char* unit_ptr(const Params& P, int u) {
    if (u < R0_UNITS) return (unsigned char*)P.out + (size_t)u * UNITB;
    if (u < R0_UNITS + R1_UNITS) return P.ws + WS_WIN + (size_t)(u - R0_UNITS) * UNITB;
    return P.ws + WS_R2 + (size_t)(u - R0_UNITS - R1_UNITS) * UNITB;
}
#define XB_TMO      128
#define XB_XCNT(j)  (256  + 64 * (j))
#define XB_XSUB(j)  (1280 + 64 * (j))
#define XB_XGEN(j)  (2304 + 64 * (j))
#define XB_TOP      3328
#define XB_TOPGEN   3392
#define XCD_BAR_WORDS 3456
#define XB_SPIN_CAP (1u << 18)
#define LAS __attribute__((address_space(3)))

__device__ __forceinline__ unsigned xb_ld(unsigned* p)              { return __hip_atomic_load(p, __ATOMIC_RELAXED, __HIP_MEMORY_SCOPE_AGENT); }
__device__ __forceinline__ unsigned xb_add(unsigned* p, unsigned v) { return __hip_atomic_fetch_add(p, v, __ATOMIC_RELAXED, __HIP_MEMORY_SCOPE_AGENT); }
__device__ __forceinline__ unsigned xb_xcc_id() { return (unsigned)__builtin_amdgcn_s_getreg((3 << 11) | 20) & 0xFu; }
#define XB_SPIN(cond, bar) do { unsigned _sp = 0; while (cond) { __builtin_amdgcn_s_sleep(1); \
    if ((++_sp & 255u) == 0u) { if (xb_ld(&(bar)[XB_TMO])) break; if (_sp > XB_SPIN_CAP) { atomicAdd(&(bar)[XB_TMO], 1u); break; } } } } while (0)

struct XcdBarrier {
    unsigned* bar; unsigned x;
    volatile LAS unsigned* st;
};

__device__ __forceinline__ XcdBarrier xcd_barrier_post(unsigned* bar, volatile LAS unsigned* st) {
    XcdBarrier b; b.bar = bar; b.x = xb_xcc_id(); b.st = st;
    if (threadIdx.x == 0) (void)xb_add(&bar[XB_XCNT(b.x)], 1u);
    return b;
}
__device__ __forceinline__ void xcd_barrier_complete(unsigned* bar, unsigned x, unsigned& nloc, unsigned& nx) {
    const unsigned G = gridDim.x * gridDim.y * gridDim.z;
    unsigned sum, cnt, mine, sp = 0u;
    for (;;) {
        sum = 0u; cnt = 0u; mine = 0u;
#pragma unroll
        for (unsigned j = 0; j < 16; ++j) { const unsigned c = xb_ld(&bar[XB_XCNT(j)]); sum += c; cnt += (c > 0u) ? 1u : 0u; mine = (j == x) ? c : mine; }
        if (sum == G) break;
        __builtin_amdgcn_s_sleep(1);
        if ((++sp & 255u) == 0u) { if (xb_ld(&bar[XB_TMO])) break; if (sp > XB_SPIN_CAP) { atomicAdd(&bar[XB_TMO], 1u); break; } }
    }
    nloc = mine > 0u ? mine : 1u; nx = cnt > 0u ? cnt : 1u;
}

__device__ __forceinline__ void xcd_barrier(const XcdBarrier& b) {
    asm volatile("s_waitcnt vmcnt(0)" ::: "memory");
    __syncthreads();
    if (threadIdx.x == 0) {
        unsigned* bar = b.bar;
        __builtin_amdgcn_s_waitcnt(0);
        unsigned nloc = b.st[0], nx = b.st[1];
        if (nloc == 0u) { xcd_barrier_complete(bar, b.x, nloc, nx); b.st[0] = nloc; b.st[1] = nx; }
        const unsigned old = xb_add(&bar[XB_XSUB(b.x)], 1u);
        const unsigned gen = old / nloc;
        if (old + 1u == (gen + 1u) * nloc) {
            __builtin_amdgcn_fence(__ATOMIC_RELEASE, "agent");
            asm volatile("s_waitcnt vmcnt(0)" ::: "memory");
            const unsigned og = xb_add(&bar[XB_TOP], 1u);
            const unsigned tg = og / nx;
            if (og + 1u == (tg + 1u) * nx) xb_add(&bar[XB_TOPGEN], 1u);
            else XB_SPIN(xb_ld(&bar[XB_TOPGEN]) == tg, bar);
            __builtin_amdgcn_fence(__ATOMIC_ACQUIRE, "agent");
            xb_add(&bar[XB_XGEN(b.x)], 1u);
            asm volatile("s_waitcnt vmcnt(0)" ::: "memory");
        } else {
            XB_SPIN(xb_ld(&bar[XB_XGEN(b.x)]) == gen, bar);
            __builtin_amdgcn_fence(__ATOMIC_ACQUIRE, "agent");
            asm volatile("s_waitcnt vmcnt(0)" ::: "memory");
        }
    }
    __syncthreads();
}
namespace pg8 {
#define PG8_LAS __attribute__((address_space(3)))
typedef unsigned short bf16_t;
typedef short bf16x8 __attribute__((ext_vector_type(8)));
typedef float f32x4 __attribute__((ext_vector_type(4)));
typedef unsigned u32x4 __attribute__((ext_vector_type(4)));
constexpr int BM = 256, BK = 64, HALF = 128, HTB = HALF * BK * 2  , STAGE_BYTES = 8 * HTB, NXCD = 8, WGM = 8;

__host__ __device__ __forceinline__ int lds_byte(int r, int c) { const int st = (r >> 4) * 2 + (c >> 5), rr = r & 15, cc = c & 31, ob = rr * 64 + cc * 2; return st * 1024 + (ob ^ (((ob >> 9) & 1) << 5)); }
__host__ __device__ __forceinline__ void stage_rc(int b, int& R, int& C) { const int st = b / 1024, sb = b % 1024, swz = sb ^ (((sb >> 9) & 1) << 5); R = (st >> 1) * 16 + swz / 64; C = (st & 1) * 32 + (swz % 64) / 2; }
__host__ __device__ __forceinline__ int perm32(int rho) { const int n = rho >> 4, i = rho & 15; return 8 * (i >> 2) + 4 * n + (i & 3); }

struct Unit { int pm, pn; };
struct Gemm { const bf16_t* A; const bf16_t* Bt; int M, N, K; };

struct StaticOrder {
    int nM, nN, nwg, G, c;
    __host__ __device__ void init(int M, int N, int G_, int c_) { nM = M / BM; nN = N / BM; nwg = nM * nN; G = G_; c = c_; }
    __host__ __device__ bool next(int i, Unit& u) const {
        const long L = (long)i * G + c; if (L >= nwg) return false;
        int wgid = (int)L; { const int q = nwg / NXCD, r = nwg % NXCD, xcd = wgid % NXCD, off = wgid / NXCD; wgid = (xcd < r ? xcd * (q + 1) : r * (q + 1) + (xcd - r) * q) + off; }
        const int nig = WGM * nN, gid = wgid / nig, fm = gid * WGM, gsz = (nM - fm) < WGM ? (nM - fm) : WGM;
        u.pm = fm + ((wgid % nig) % gsz); u.pn = (wgid % nig) / gsz; return true;
    }
    __device__ __forceinline__ void a_ready(const Unit&) const {}
    __device__ __forceinline__ void done(const Unit&) const {}
};
struct CountedOrder : StaticOrder {
    const unsigned* ready; unsigned need; unsigned* tmo;
    __device__ __forceinline__ void a_ready(const Unit& u) const {
        if (threadIdx.x < 64) {
            const unsigned long long t0 = __builtin_amdgcn_s_memrealtime(); unsigned polls = 0;
            while ((unsigned)__builtin_amdgcn_readfirstlane(__hip_atomic_load(ready + 64 * u.pm, __ATOMIC_RELAXED, __HIP_MEMORY_SCOPE_AGENT)) < need) {
                if ((++polls & 255u) == 0u && __builtin_amdgcn_readfirstlane(__hip_atomic_load(tmo, __ATOMIC_RELAXED, __HIP_MEMORY_SCOPE_AGENT)) != 0u) break;
                if (__builtin_amdgcn_s_memrealtime() - t0 > 2000000ull) {
                    if (threadIdx.x == 0) { unsigned expect = 0u; __hip_atomic_compare_exchange_strong(tmo + 1, &expect, 0x600u | (unsigned)(u.pm & 0xff), __ATOMIC_RELAXED, __ATOMIC_RELAXED, __HIP_MEMORY_SCOPE_AGENT); __hip_atomic_store(tmo, 1u, __ATOMIC_RELAXED, __HIP_MEMORY_SCOPE_AGENT); }
                    break; }
                __builtin_amdgcn_s_sleep(2); }
            __builtin_amdgcn_fence(__ATOMIC_ACQUIRE, "agent");
            asm volatile("s_waitcnt vmcnt(0)" ::: "memory");
        }
#if !defined(BROKEN_HOOK_NO_BARRIER)
        asm volatile("" ::: "memory"); __builtin_amdgcn_s_barrier(); asm volatile("" ::: "memory");
#endif
    }
};
__device__ __forceinline__ u32x4 pack8(const f32x4 a, const f32x4 b) { u32x4 w; w.x = cvt_pk_bf16(a[0], a[1]); w.y = cvt_pk_bf16(a[2], a[3]); w.z = cvt_pk_bf16(b[0], b[1]); w.w = cvt_pk_bf16(b[2], b[3]); return w; }

struct EpiIn {
    static constexpr bool PERM = true, AFTER_DRAIN = false;
    float* out; unsigned char* ws;
    __device__ __forceinline__ void operator()(const f32x4 (&acc)[2][2][4][2], const Unit& u, int wr, int wc, int fr, int fq) const {
        const int pn = u.pn;
#pragma unroll
        for (int ai = 0; ai < 2; ++ai)
#pragma unroll
            for (int m = 0; m < 4; ++m) {
                const int r = u.pm * BM + ai * HALF + wr * 64 + m * 16 + fr;
                const bool isP = r < SEQ; const int rs = r - SEQ;
#pragma unroll
                for (int bj = 0; bj < 2; ++bj) {
                    const int cb = bj * HALF + wc * 32 + 8 * fq;
                    f32x4 v0 = acc[ai][bj][m][0], v1 = acc[ai][bj][m][1];
                    if (pn < 8) {
                        *(u32x4*)((bf16_t*)(ws + WS_Q) + (size_t)r * DM + pn * 256 + cb) = pack8(v0, v1);
                    } else if (pn < 24) {
                        const bool isK = pn < 16; const int col = (pn - (isK ? 8 : 16)) * 256 + cb;
                        float* dst = out + (isP ? (isK ? O_KP : O_VP) + (size_t)r * DM : (isK ? O_KS : O_VS) + (size_t)rs * DM) + col;
                        *(f32x4*)dst = v0; *(f32x4*)(dst + 4) = v1;
                        if (isP) *(u32x4*)((bf16_t*)(ws + (isK ? WS_KP : WS_VP)) + (size_t)r * DM + col) = pack8(v0, v1);
                    } else if (pn < 28) {
                        *(u32x4*)((bf16_t*)(ws + WS_QI) + (size_t)r * 1024 + (pn - 24) * 256 + cb) = pack8(v0, v1);
                    } else if (pn < 52) {
                        const int col = (pn - 28) * 256 + cb;
                        *(u32x4*)((bf16_t*)(ws + WS_QKVB) + (size_t)r * CONVB + col) = pack8(v0, v1);
                        const int t = isP ? r - (SEQ - 64) : (rs & 63);
                        if (t >= 61 && t < 64) {
                            float* dst = out + (isP ? O_CBP : O_CBS + (size_t)(rs >> 6) * 3 * CONVB) + (size_t)(t - 61) * CONVB + col;
                            *(f32x4*)dst = v0; *(f32x4*)(dst + 4) = v1;
                        }
                    } else if (pn < 76) {
                        const int seg = (pn - 52) >> 3; const int col = ((pn - 52) & 7) * 256 + cb;
#pragma unroll
                        for (int j = 0; j < 4; ++j) {
                            if (seg == 0) { v0[j] = siluf_(v0[j]); v1[j] = siluf_(v1[j]); } else { v0[j] = sigmoidf_(v0[j]); v1[j] = sigmoidf_(v1[j]); }
                        }
                        *(u32x4*)((bf16_t*)(ws + (seg == 0 ? WS_Z : (seg == 1 ? WS_GA : WS_GB))) + (size_t)r * DM + col) = pack8(v0, v1);
                    } else {
                        if (cb < 64) {
                            float* dst = out + (isP ? O_KIP + (size_t)r * 64 : O_KIS + (size_t)rs * 64) + cb;
                            *(f32x4*)dst = v0; *(f32x4*)(dst + 4) = v1;
                            bf16_t* kb = isP ? (bf16_t*)(ws + WS_KIP) + (size_t)r * 64 : (bf16_t*)(ws + WS_KIS) + ((size_t)(rs >> 6) * LS + PAST + (rs & 63)) * 64;
                            *(u32x4*)(kb + cb) = pack8(v0, v1);
                        } else if (cb < 112) {
                            const int which = cb < 80 ? 0 : (cb < 96 ? 1 : 2); const int c16 = cb - (which == 0 ? 64 : (which == 1 ? 80 : 96));
                            float* dst = (float*)(ws + (which == 0 ? WS_WI : (which == 1 ? WS_AB : WS_BB))) + (size_t)r * 16 + c16;
                            const float sc = which == 0 ? 0.03125f : 1.0f;
                            *(f32x4*)dst = v0 * sc; *(f32x4*)(dst + 4) = v1 * sc;
                        }
                    }
                }
            }
    }
};

template <int WHICH> struct EpiRes {
    static constexpr bool PERM = false, AFTER_DRAIN = false;
    const float* xp; const float* xs; float* Y; const float* mod;
    __device__ __forceinline__ void operator()(const f32x4 (&acc)[2][2][4][2], const Unit& u, int wr, int wc, int fr, int fq) const {
#pragma unroll
        for (int ai = 0; ai < 2; ++ai)
#pragma unroll
            for (int m = 0; m < 4; ++m) {
                const int r = u.pm * BM + ai * HALF + wr * 64 + m * 16 + fr;
                const int s = seq_of_row(r);
                const float* gate = mod + (size_t)s * 12288 + (WHICH == 0 ? 4096 : 10240);
                const float* base = WHICH == 0 ? (r < SEQ ? xp + (size_t)r * DM : xs + (size_t)(r - SEQ) * DM) : Y + (size_t)r * DM;
                float* dst = Y + (size_t)r * DM;
#pragma unroll
                for (int bj = 0; bj < 2; ++bj)
#pragma unroll
                    for (int n = 0; n < 2; ++n) {
                        const int c = u.pn * BM + bj * HALF + wc * 32 + n * 16 + 4 * fq;
                        const f32x4 g = *(const f32x4*)(gate + c), b = *(const f32x4*)(base + c);
                        *(f32x4*)(dst + c) = b + g * acc[ai][bj][m][n];
                    }
            }
    }
};

struct EpiGU {
    static constexpr bool PERM = true, AFTER_DRAIN = false;
    float* out; unsigned char* ws;
    __device__ __forceinline__ void operator()(const f32x4 (&acc)[2][2][4][2], const Unit& u, int wr, int wc, int fr, int fq) const {
#pragma unroll
        for (int ai = 0; ai < 2; ++ai)
#pragma unroll
            for (int m = 0; m < 4; ++m) {
                const int r = u.pm * BM + ai * HALF + wr * 64 + m * 16 + fr;
                const bool isP = r < SEQ; const int rs = r - SEQ;
                const int col = u.pn * 128 + wc * 32 + 8 * fq;
                const f32x4 g0 = acc[ai][0][m][0], g1 = acc[ai][0][m][1];
                *(u32x4*)((bf16_t*)(ws + WS_GP) + (size_t)r * DFF + col) = pack8(g0, g1);
                *(u32x4*)((bf16_t*)(ws + WS_UP) + (size_t)r * DFF + col) = pack8(acc[ai][1][m][0], acc[ai][1][m][1]);
                const int t = isP ? r - (SEQ - 64) : (rs & 63);
                if (t >= 62 && t < 64) {
                    float* dst = out + (isP ? O_FP : O_FS + (size_t)(rs >> 6) * 2 * DFF) + (size_t)(t - 62) * DFF + col;
                    *(f32x4*)dst = g0; *(f32x4*)(dst + 4) = g1;
                }
            }
    }
};

template <class Epi, class Sched, bool STAMP = false>
__device__ __forceinline__ void gemm_phase(PG8_LAS unsigned char* lds, const Gemm g, const Sched& S, const Epi& E, unsigned long long* stamps) {
    const int tid = threadIdx.x, wid = __builtin_amdgcn_readfirstlane(tid >> 6), lane = tid & 63, wr = wid >> 2, wc = wid & 3, fr = lane & 15, fq = lane >> 4;
    const int K = g.K, nt = K / BK;
    int ts_lo = 0, ts_hi = 0, nts = 0; const unsigned long long rt_entry = STAMP ? (unsigned long long)wall_clock64() : 0ull;
#define PG8_STAMP() do { if (STAMP && wid == 0 && nts < 64) { const unsigned long long _c = (unsigned long long)clock64(); \
        ts_lo = (lane == nts) ? (int)(unsigned)_c : ts_lo; ts_hi = (lane == nts) ? (int)(unsigned)(_c >> 32) : ts_hi; ++nts; } } while (0)
    PG8_STAMP();
    unsigned voffA[2], voffB[2];
#pragma unroll
    for (int i = 0; i < 2; ++i) { int R, C; stage_rc(tid * 16 + i * 8192, R, C); const int Rb = Epi::PERM ? ((R & ~31) + perm32(R & 31)) : R;
        voffA[i] = (unsigned)(R * K + C) * 2u; voffB[i] = (unsigned)(Rb * K + C) * 2u; }
    const size_t kstep = (size_t)(BK * 2);
    const size_t hstep = (size_t)HALF * K * 2;
    const size_t tstep = 2 * hstep;
    const unsigned ldsw = (unsigned)wid * 1024u;
    const int aoff = lds_byte(wr * 64 + fr, fq * 8), boff = lds_byte(wc * 32 + fr, fq * 8);
#define PG8_SA(b, h) (((b) * 2 + (h)) * HTB)
#define PG8_SB(b, h) ((4 + (b) * 2 + (h)) * HTB)
#define PG8_STAGE(bufoff, gbase, voff) do { _Pragma("unroll") for (int _i = 0; _i < 2; ++_i) \
        __builtin_amdgcn_global_load_lds((const unsigned*)((const char*)(gbase) + (voff)[_i]), (PG8_LAS unsigned*)(lds + (bufoff) + ldsw + _i * 8192), 16, 0, 0); } while (0)
#define PG8_LDA(dst, b, h) do { _Pragma("unroll") for (int m = 0; m < 4; ++m) _Pragma("unroll") for (int k = 0; k < 2; ++k) dst[m][k] = *(const PG8_LAS bf16x8*)(lds + PG8_SA(b, h) + aoff + m * 2048 + k * 1024); } while (0)
#define PG8_LDB(dst, b, h) do { _Pragma("unroll") for (int n = 0; n < 2; ++n) _Pragma("unroll") for (int k = 0; k < 2; ++k) dst[n][k] = *(const PG8_LAS bf16x8*)(lds + PG8_SB(b, h) + boff + n * 2048 + k * 1024); } while (0)
#define PG8_MMA(ai, bj, At, Bt) do { __builtin_amdgcn_s_setprio(1); _Pragma("unroll") for (int m = 0; m < 4; ++m) _Pragma("unroll") for (int n = 0; n < 2; ++n) _Pragma("unroll") for (int k = 0; k < 2; ++k) \
        acc[ai][bj][m][n] = __builtin_amdgcn_mfma_f32_16x16x32_bf16(Bt[n][k], At[m][k], acc[ai][bj][m][n], 0, 0, 0); __builtin_amdgcn_s_setprio(0); } while (0)
#define PG8_WAIT_V(n) asm volatile("s_waitcnt vmcnt(" #n ")" ::: "memory")
#define PG8_WAIT_L(n) asm volatile("s_waitcnt lgkmcnt(" #n ")" ::: "memory")
#define PG8_BAR __builtin_amdgcn_s_barrier()
#define PG8_SCHED __builtin_amdgcn_sched_barrier(0)
    Unit cur, nxt; int ui = 0;
    if (!S.next(0, cur)) return;
    f32x4 acc[2][2][4][2];
#pragma unroll
    for (int a = 0; a < 2; ++a)
#pragma unroll
        for (int b = 0; b < 2; ++b)
#pragma unroll
            for (int m = 0; m < 4; ++m)
#pragma unroll
                for (int n = 0; n < 2; ++n) acc[a][b][m][n] = (f32x4){0.f, 0.f, 0.f, 0.f};
    bf16x8 At[4][2], B0[2][2], B1[2][2];
    const char* cA = (const char*)g.A + (size_t)cur.pm * tstep; const char* cB = (const char*)g.Bt + (size_t)cur.pn * tstep;
    S.a_ready(cur);
    PG8_STAGE(PG8_SB(0, 0), cB, voffB); PG8_STAGE(PG8_SA(0, 0), cA, voffA); PG8_STAGE(PG8_SB(0, 1), cB + hstep, voffB); PG8_STAGE(PG8_SA(0, 1), cA + hstep, voffA);
    if (wr == 1) PG8_BAR;
    PG8_WAIT_V(4); PG8_BAR;
    PG8_STAGE(PG8_SB(1, 0), cB + kstep, voffB); PG8_STAGE(PG8_SA(1, 0), cA + kstep, voffA); PG8_STAGE(PG8_SB(1, 1), cB + hstep + kstep, voffB);
    PG8_WAIT_V(6); PG8_BAR;
    PG8_STAMP();
    for (;;) {
        const bool has_next = S.next(ui + 1, nxt);
        const char* nA = has_next ? (const char*)g.A + (size_t)nxt.pm * tstep : cA; const char* nB = has_next ? (const char*)g.Bt + (size_t)nxt.pn * tstep : cB;
        for (int t = 0; t < nt; t += 2) {
            const bool last = (t == nt - 2);
            const char* a1 = cA + (size_t)(t + 1) * kstep;
            const char* a2 = last ? nA : cA + (size_t)(t + 2) * kstep; const char* b2 = last ? nB : cB + (size_t)(t + 2) * kstep;
            const char* a3 = a2 + kstep; const char* b3 = b2 + kstep;
            if (last && has_next) S.a_ready(nxt);
            PG8_LDB(B0, 0, 0); PG8_SCHED; PG8_LDA(At, 0, 0); PG8_STAGE(PG8_SA(1, 1), a1 + hstep, voffA);
            PG8_WAIT_L(8); PG8_BAR; PG8_WAIT_L(0); PG8_MMA(0, 0, At, B0); PG8_BAR; PG8_SCHED;
            PG8_LDB(B1, 0, 1); PG8_STAGE(PG8_SB(0, 0), b2, voffB);
            PG8_BAR; PG8_WAIT_L(0); PG8_MMA(0, 1, At, B1); PG8_BAR;
            PG8_LDA(At, 0, 1); PG8_STAGE(PG8_SA(0, 0), a2, voffA);
            PG8_BAR; PG8_WAIT_L(0); PG8_MMA(1, 0, At, B0); PG8_BAR; PG8_SCHED;
            PG8_STAGE(PG8_SB(0, 1), b2 + hstep, voffB);
            PG8_WAIT_V(6); PG8_BAR; PG8_MMA(1, 1, At, B1); PG8_BAR;
            PG8_LDB(B0, 1, 0); PG8_SCHED; PG8_LDA(At, 1, 0); PG8_STAGE(PG8_SA(0, 1), a2 + hstep, voffA);
            PG8_WAIT_L(8); PG8_BAR; PG8_WAIT_L(0); PG8_MMA(0, 0, At, B0); PG8_BAR; PG8_SCHED;
            PG8_LDB(B1, 1, 1); PG8_STAGE(PG8_SB(1, 0), b3, voffB);
            PG8_BAR; PG8_WAIT_L(0); PG8_MMA(0, 1, At, B1); PG8_BAR;
            PG8_LDA(At, 1, 1); PG8_STAGE(PG8_SA(1, 0), a3, voffA);
            PG8_BAR; PG8_WAIT_L(0); PG8_MMA(1, 0, At, B0); PG8_BAR; PG8_SCHED;
            PG8_STAGE(PG8_SB(1, 1), b3 + hstep, voffB);
            PG8_WAIT_V(6); PG8_BAR; PG8_MMA(1, 1, At, B1); PG8_BAR;
        }
        PG8_STAMP();
        if constexpr (!Epi::AFTER_DRAIN) { E(acc, cur, wr, wc, fr, fq); S.done(cur); }
        PG8_STAMP();
        if (!has_next) break;
#pragma unroll
        for (int a = 0; a < 2; ++a)
#pragma unroll
            for (int b = 0; b < 2; ++b)
#pragma unroll
                for (int m = 0; m < 4; ++m)
#pragma unroll
                    for (int n = 0; n < 2; ++n) acc[a][b][m][n] = (f32x4){0.f, 0.f, 0.f, 0.f};
        cur = nxt; cA = nA; cB = nB; ++ui;
    }
    PG8_WAIT_V(0);
    if (wr == 0) PG8_BAR;
    PG8_BAR;
    if constexpr (Epi::AFTER_DRAIN) { E.fused(acc, cur, wr, wc, fr, fq, lds, wid, lane); S.done(cur); }
    PG8_STAMP();
    if (STAMP && wid == 0) { stamps[lane] = lane < nts ? (((unsigned long long)(unsigned)ts_hi << 32) | (unsigned)ts_lo) : 0ull;
        if (lane == 62) stamps[62] = rt_entry; if (lane == 63) stamps[63] = (unsigned long long)wall_clock64(); }
#undef PG8_STAMP
#undef PG8_SA
#undef PG8_SB
#undef PG8_STAGE
#undef PG8_LDA
#undef PG8_LDB
#undef PG8_MMA
#undef PG8_WAIT_V
#undef PG8_WAIT_L
#undef PG8_BAR
#undef PG8_SCHED
}
}
__device__ __forceinline__ void adaln_phase(const Params& P, LAS unsigned char* lds) {
    int tid = threadIdx.x; asm volatile("" : "+v"(tid)); const int w = tid >> 6, lane = tid & 63;
    LAS float* sc = (LAS float*)lds;
    LAS float* red = (LAS float*)(lds + 33792);
    const float* cp = P.in[2]; const float* cs = P.in[3]; const float* wada = P.in[12]; const float* bada = P.in[13];
    float* mod = (float*)(P.ws + WS_MOD);
    for (int j = blockIdx.x; j < 192; j += gridDim.x) {
        float acc[NSEQ];
#pragma unroll
        for (int s = 0; s < NSEQ; ++s) acc[s] = 0.f;
        for (int kc = 0; kc < 8; ++kc) {
            const int k0 = kc * 256;
            __syncthreads();
            for (int idx = tid; idx < NSEQ * 256; idx += NTHREADS) {
                const int s = idx >> 8, kk = idx & 255;
                const float c = s == 0 ? cp[k0 + kk] : cs[(size_t)(s - 1) * DM + k0 + kk];
                sc[idx] = c / (1.0f + expf(-c));
            }
            __syncthreads();
            for (int kk = 0; kk < 32; kk += 4) {
                float wv[4];
#pragma unroll
                for (int q = 0; q < 4; ++q) wv[q] = wada[(size_t)(k0 + 32 * w + kk + q) * 12288 + 64 * j + lane];
#pragma unroll
                for (int s = 0; s < NSEQ; ++s) {
                    const f32x4 c4 = *(const LAS f32x4*)(sc + s * 256 + 32 * w + kk);
                    acc[s] = fmaf(c4[0], wv[0], acc[s]); acc[s] = fmaf(c4[1], wv[1], acc[s]); acc[s] = fmaf(c4[2], wv[2], acc[s]); acc[s] = fmaf(c4[3], wv[3], acc[s]);
                }
            }
        }
#pragma unroll
        for (int s = 0; s < NSEQ; ++s) red[(w * NSEQ + s) * 64 + lane] = acc[s];
        __syncthreads();
        for (int idx = tid; idx < NSEQ * 64; idx += NTHREADS) {
            const int s = idx >> 6, col = idx & 63; float v = bada[64 * j + col];
#pragma unroll
            for (int ww = 0; ww < 8; ++ww) v += red[(ww * NSEQ + s) * 64 + col];
            mod[(size_t)s * 12288 + 64 * j + col] = v;
        }
        __syncthreads();
    }
}

__device__ __forceinline__ int win_src_col(int n) {
    if (n < 7168) return n;
    if (n < 13312) return 7248 + (n - 7168);
    if (n < 19456) return 13424 + (n - 13312);
    const int q = n - 19456;
    if (q < 80) return 7168 + q;
    if (q < 112) return 13392 + (q - 80);
    return -1;
}
__device__ __forceinline__ void xpose_phase(const Params& P, LAS unsigned char* lds) {
    int tid = threadIdx.x; asm volatile("" : "+v"(tid)); const int tx = tid & 63, ty = tid >> 6, nl = tid >> 3, ks = tid & 7;
    LAS float* tile = (LAS float*)lds;
    constexpr int J0 = 308 * 32, J1 = J0 + 32 * 32, J2 = J1 + 176 * 32, J3 = J2 + 32 * 88;
    for (int j = blockIdx.x; j < J3; j += gridDim.x) {
        const float* src; int ld, K, nt, kt, sc; bf16_t* dst;
        if (j < J0)      { nt = j >> 5; kt = j & 31; src = P.in[15]; ld = DIN; K = DM; dst = (bf16_t*)(P.ws + WS_WIN); sc = win_src_col(nt * 64 + tx); }
        else if (j < J1) { const int q = j - J0; nt = q >> 5; kt = q & 31; src = P.in[20]; ld = DM; K = DM; dst = (bf16_t*)(P.ws + WS_WOUT); sc = nt * 64 + tx; }
        else if (j < J2) { const int q = j - J1; nt = q >> 5; kt = q & 31; K = DM; ld = DFF; dst = (bf16_t*)(P.ws + WS_WGU);
                           const int n = nt * 64 + tx, pn = n >> 8, wi = n & 255; src = wi < 128 ? P.in[22] : P.in[25]; sc = pn * 128 + (wi & 127); }
        else             { const int q = j - J2; nt = q / 88; kt = q % 88; src = P.in[26]; ld = DM; K = DFF; dst = (bf16_t*)(P.ws + WS_WDN); sc = nt * 64 + tx; }
        const int k0 = kt * 64;
#pragma unroll
        for (int i = 0; i < 8; ++i) { const int kk = ty + 8 * i; tile[kk * 65 + tx] = sc >= 0 ? src[(size_t)(k0 + kk) * ld + sc] : 0.f; }
        __syncthreads();
        float v[8];
#pragma unroll
        for (int q = 0; q < 8; ++q) v[q] = tile[(ks * 8 + q) * 65 + nl];
        u32x4 wv; wv.x = cvt_pk_bf16(v[0], v[1]); wv.y = cvt_pk_bf16(v[2], v[3]); wv.z = cvt_pk_bf16(v[4], v[5]); wv.w = cvt_pk_bf16(v[6], v[7]);
        *(u32x4*)(dst + (size_t)(nt * 64 + nl) * K + k0 + ks * 8) = wv;
        __syncthreads();
    }
}

template <int WHICH> __device__ __forceinline__ void normmod_phase(const Params& P) {
    int tid = threadIdx.x; asm volatile("" : "+v"(tid)); const int w = tid >> 6, lane = tid & 63;
    const float* g = P.in[WHICH == 0 ? 14 : 21]; const float* mod = (const float*)(P.ws + WS_MOD);
    bf16_t* H = (bf16_t*)(P.ws + WS_H);
    for (int row = blockIdx.x * 8 + w; row < MT; row += gridDim.x * 8) {
        const float* src = WHICH == 0 ? (row < SEQ ? P.in[0] + (size_t)row * DM : P.in[1] + (size_t)(row - SEQ) * DM) : P.out + (size_t)row * DM;
        const int s = seq_of_row(row);
        const float* sh = mod + (size_t)s * 12288 + (WHICH == 0 ? 0 : 6144); const float* sl = sh + 2048;
        f32x4 v[8]; float ss = 0.f;
#pragma unroll
        for (int j = 0; j < 8; ++j) { v[j] = *(const f32x4*)(src + lane * 4 + 256 * j); ss += v[j][0] * v[j][0] + v[j][1] * v[j][1] + v[j][2] * v[j][2] + v[j][3] * v[j][3]; }
        ss = wave_sum(ss);
        const float rstd = rsqrtf(ss * (1.0f / DM) + 1e-6f);
#pragma unroll
        for (int j = 0; j < 8; ++j) {
            const int c = lane * 4 + 256 * j;
            const f32x4 gg = *(const f32x4*)(g + c), a = *(const f32x4*)(sl + c), b = *(const f32x4*)(sh + c);
            const f32x4 y = (v[j] * rstd * gg) * (1.0f + a) + b;
            u32x2 o; o.x = cvt_pk_bf16(y[0], y[1]); o.y = cvt_pk_bf16(y[2], y[3]);
            *(u32x2*)(H + (size_t)row * DM + c) = o;
        }
    }
}

__device__ __forceinline__ void finalnorm_phase(const Params& P) {
    int tid = threadIdx.x; asm volatile("" : "+v"(tid)); const int w = tid >> 6, lane = tid & 63;
    const float* g = P.in[11];
    for (int row = blockIdx.x * 8 + w; row < MT; row += gridDim.x * 8) {
        float* src = P.out + (size_t)row * DM;
        f32x4 v[8]; float ss = 0.f;
#pragma unroll
        for (int j = 0; j < 8; ++j) { v[j] = *(const f32x4*)(src + lane * 4 + 256 * j); ss += v[j][0] * v[j][0] + v[j][1] * v[j][1] + v[j][2] * v[j][2] + v[j][3] * v[j][3]; }
        ss = wave_sum(ss);
        const float rstd = rsqrtf(ss * (1.0f / DM) + 1e-6f);
#pragma unroll
        for (int j = 0; j < 8; ++j) { const int c = lane * 4 + 256 * j; *(f32x4*)(src + c) = v[j] * rstd * *(const f32x4*)(g + c); }
    }
}

__device__ __forceinline__ void act_phase(const Params& P) {
    const bf16_t* GP = (const bf16_t*)(P.ws + WS_GP); bf16_t* UP = (bf16_t*)(P.ws + WS_UP);
    const float* cw = P.in[23]; const float* cb = P.in[24]; const float* st = P.in[9];
    constexpr int NCG = DFF / 8, NRB = MT / 32;
    for (int task = blockIdx.x * NTHREADS + threadIdx.x; task < NCG * NRB; task += gridDim.x * NTHREADS) {
        const int cg = task % NCG, rb = task / NCG, f = cg * 8, m0 = rb * 32;
        float w0[8], w1[8], w2[8], bb[8], xm2[8], xm1[8];
#pragma unroll
        for (int q = 0; q < 8; ++q) { w0[q] = cw[f + q]; w1[q] = cw[DFF + f + q]; w2[q] = cw[2 * DFF + f + q]; bb[q] = cb[f + q]; }
        const bool isP = m0 < SEQ; const int t0 = isP ? m0 : ((m0 - SEQ) & 63);
        if (t0 == 0) {
            if (isP) {
#pragma unroll
                for (int q = 0; q < 8; ++q) { xm2[q] = 0.f; xm1[q] = 0.f; }
            } else {
                const float* sp = st + (size_t)((m0 - SEQ) >> 6) * 2 * DFF + f;
#pragma unroll
                for (int q = 0; q < 8; ++q) { xm2[q] = sp[q]; xm1[q] = sp[DFF + q]; }
            }
        } else {
            const u32x4 a = *(const u32x4*)(GP + (size_t)(m0 - 2) * DFF + f), b = *(const u32x4*)(GP + (size_t)(m0 - 1) * DFF + f);
            xm2[0] = bflo(a.x); xm2[1] = bfhi(a.x); xm2[2] = bflo(a.y); xm2[3] = bfhi(a.y); xm2[4] = bflo(a.z); xm2[5] = bfhi(a.z); xm2[6] = bflo(a.w); xm2[7] = bfhi(a.w);
            xm1[0] = bflo(b.x); xm1[1] = bfhi(b.x); xm1[2] = bflo(b.y); xm1[3] = bfhi(b.y); xm1[4] = bflo(b.z); xm1[5] = bfhi(b.z); xm1[6] = bflo(b.w); xm1[7] = bfhi(b.w);
        }
        for (int i = 0; i < 32; ++i) {
            const size_t off = (size_t)(m0 + i) * DFF + f;
            const u32x4 gq = *(const u32x4*)(GP + off), uq = *(const u32x4*)(UP + off);
            float x0[8], uu[8], y[8];
            x0[0] = bflo(gq.x); x0[1] = bfhi(gq.x); x0[2] = bflo(gq.y); x0[3] = bfhi(gq.y); x0[4] = bflo(gq.z); x0[5] = bfhi(gq.z); x0[6] = bflo(gq.w); x0[7] = bfhi(gq.w);
            uu[0] = bflo(uq.x); uu[1] = bfhi(uq.x); uu[2] = bflo(uq.y); uu[3] = bfhi(uq.y); uu[4] = bflo(uq.z); uu[5] = bfhi(uq.z); uu[6] = bflo(uq.w); uu[7] = bfhi(uq.w);
#pragma unroll
            for (int q = 0; q < 8; ++q) { const float a = fmaf(w0[q], xm2[q], fmaf(w1[q], xm1[q], fmaf(w2[q], x0[q], bb[q]))); y[q] = siluf_(a) * uu[q]; xm2[q] = xm1[q]; xm1[q] = x0[q]; }
            u32x4 o; o.x = cvt_pk_bf16(y[0], y[1]); o.y = cvt_pk_bf16(y[2], y[3]); o.z = cvt_pk_bf16(y[4], y[5]); o.w = cvt_pk_bf16(y[6], y[7]);
            *(u32x4*)(UP + off) = o;
        }
    }
}

__device__ __forceinline__ void merge_phase(const Params& P) {
    const bf16_t* OA = (const bf16_t*)(P.ws + WS_Q); const bf16_t* OB = (const bf16_t*)(P.ws + WS_OB);
    const bf16_t* Z = (const bf16_t*)(P.ws + WS_Z); const bf16_t* GA = (const bf16_t*)(P.ws + WS_GA); const bf16_t* GB = (const bf16_t*)(P.ws + WS_GB);
    const float* gdn = P.in[19]; bf16_t* MIX = (bf16_t*)(P.ws + WS_H);
    const size_t total = (size_t)MT * DM / 8;
    for (size_t task = (size_t)blockIdx.x * NTHREADS + threadIdx.x; task < total; task += (size_t)gridDim.x * NTHREADS) {
        const size_t off = task * 8; const int dv = (int)(off & 127);
        const u32x4 oa = *(const u32x4*)(OA + off), ob = *(const u32x4*)(OB + off), z = *(const u32x4*)(Z + off), ga = *(const u32x4*)(GA + off), gb = *(const u32x4*)(GB + off);
        float b[8] = {bflo(ob.x), bfhi(ob.x), bflo(ob.y), bfhi(ob.y), bflo(ob.z), bfhi(ob.z), bflo(ob.w), bfhi(ob.w)};
        float ss = 0.f;
#pragma unroll
        for (int q = 0; q < 8; ++q) ss += b[q] * b[q];
        ss += __shfl_xor(ss, 1); ss += __shfl_xor(ss, 2); ss += __shfl_xor(ss, 4); ss += __shfl_xor(ss, 8);
        const float rstd = rsqrtf(ss * (1.0f / 128.0f) + 1e-6f);
        const float a[8] = {bflo(oa.x), bfhi(oa.x), bflo(oa.y), bfhi(oa.y), bflo(oa.z), bfhi(oa.z), bflo(oa.w), bfhi(oa.w)};
        const float zz[8] = {bflo(z.x), bfhi(z.x), bflo(z.y), bfhi(z.y), bflo(z.z), bfhi(z.z), bflo(z.w), bfhi(z.w)};
        const float g1[8] = {bflo(ga.x), bfhi(ga.x), bflo(ga.y), bfhi(ga.y), bflo(ga.z), bfhi(ga.z), bflo(ga.w), bfhi(ga.w)};
        const float g2[8] = {bflo(gb.x), bfhi(gb.x), bflo(gb.y), bfhi(gb.y), bflo(gb.z), bfhi(gb.z), bflo(gb.w), bfhi(gb.w)};
        float y[8];
#pragma unroll
        for (int q = 0; q < 8; ++q) y[q] = g1[q] * a[q] + g2[q] * (b[q] * rstd * gdn[dv + q] * zz[q]);
        u32x4 o; o.x = cvt_pk_bf16(y[0], y[1]); o.y = cvt_pk_bf16(y[2], y[3]); o.z = cvt_pk_bf16(y[4], y[5]); o.w = cvt_pk_bf16(y[6], y[7]);
        *(u32x4*)(MIX + off) = o;
    }
}
__device__ __forceinline__ void d1_phase(const Params& P, LAS unsigned char* lds) {
    const int grp = threadIdx.x >> 8;
    LAS unsigned char* base = lds + grp * 53248;
    LAS unsigned char* Kraw = base;
    LAS unsigned char* Qraw = base + 16384;
    LAS float* Ml = (LAS float*)(base + 32768);
    LAS float* GC = (LAS float*)(base + 49152); LAS float* BETA = GC + 64; LAS float* EG = GC + 128; LAS float* EKD = GC + 192; LAS float* RK = GC + 256; LAS float* RQ = GC + 320;
    const bf16_t* QKVB = (const bf16_t*)(P.ws + WS_QKVB);
    const float* ABp = (const float*)(P.ws + WS_AB); const float* BBp = (const float*)(P.ws + WS_BB); float* GL = (float*)(P.ws + WS_GL);
    const float* cw = P.in[16]; const float* stc = P.in[7];
    for (int ub = blockIdx.x * 2; ub < NUNIT; ub += gridDim.x * 2) {
        int tid = threadIdx.x; asm volatile("" : "+v"(tid));
        const int tg = tid & 255, wg4 = __builtin_amdgcn_readfirstlane((tid >> 6) & 3), lane = tid & 63, r32 = lane & 31, hi = lane >> 5;
        const int u = ub + grp, sq = u >> 4, h = u & 15;
        const bool isS = sq >= 256; const int bsm = sq - 256;
        const int m0 = isS ? SEQ + 64 * bsm : 64 * sq;
        unsigned char* ublk = unit_ptr(P, u);
        if (tg < 64) {
            const int t = tg;
            const float ab = ABp[(size_t)(m0 + t) * 16 + h], bb = BBp[(size_t)(m0 + t) * 16 + h];
            const float x = ab + P.in[18][h];
            const float sp = x > 20.f ? x : log1pf(expf(x));
            float gcv = -expf(P.in[17][h]) * sp;
#pragma unroll
            for (int off = 1; off < 64; off <<= 1) { const float v = __shfl_up(gcv, off); if (lane >= off) gcv += v; }
            const float gcl = __shfl(gcv, 63);
            GC[t] = gcv; BETA[t] = 1.0f / (1.0f + expf(-bb)); EG[t] = expf(gcv); EKD[t] = expf(gcl - gcv);
            if (t == 63) GL[u] = expf(gcv);
        }
        float xr[64];
        {
            const int col = (wg4 < 2 ? 4096 + h * 128 + wg4 * 64 : 2048 + h * 128 + (wg4 - 2) * 64) + lane;
            const float w0 = cw[col], w1 = cw[CONVB + col], w2 = cw[2 * CONVB + col], w3 = cw[3 * CONVB + col];
            float xm3, xm2, xm1;
            if (isS) { const float* sp = stc + (size_t)bsm * 3 * CONVB + col; xm3 = sp[0]; xm2 = sp[CONVB]; xm1 = sp[2 * CONVB]; }
            else if (sq == 0) { xm3 = 0.f; xm2 = 0.f; xm1 = 0.f; }
            else { const bf16_t* pp = QKVB + (size_t)(m0 - 3) * CONVB + col; xm3 = bf2f(pp[0]); xm2 = bf2f(pp[CONVB]); xm1 = bf2f(pp[2 * CONVB]); }
            const bf16_t* px = QKVB + (size_t)m0 * CONVB + col;
#pragma unroll
            for (int tb = 0; tb < 64; tb += 16) {
                bf16_t xin[16];
#pragma unroll
                for (int t = 0; t < 16; ++t) xin[t] = px[(size_t)(tb + t) * CONVB];
#pragma unroll
                for (int t = 0; t < 16; ++t) {
                    const float x = bf2f(xin[t]);
                    const float y = fmaf(w0, xm3, fmaf(w1, xm2, fmaf(w2, xm1, w3 * x)));
                    xr[tb + t] = y / (1.0f + expf(-y));
                    xm3 = xm2; xm2 = xm1; xm1 = x;
                }
                asm volatile("" ::: "memory");
            }
            if (wg4 >= 2) {
                const int dk = (wg4 - 2) * 64 + lane;
#pragma unroll
                for (int t = 0; t < 64; ++t) *(LAS bf16_t*)(Kraw + t * 256 + ((((dk >> 3) ^ (t & 15))) << 4) + (dk & 7) * 2) = f2bf(xr[t]);
            }
        }
        {
            const int dq = tg & 127, half = tg >> 7, col = h * 128 + dq, ts = 32 * half;
            const float w0 = cw[col], w1 = cw[CONVB + col], w2 = cw[2 * CONVB + col], w3 = cw[3 * CONVB + col];
            float xm3, xm2, xm1;
            if (half == 0 && isS) { const float* sp = stc + (size_t)bsm * 3 * CONVB + col; xm3 = sp[0]; xm2 = sp[CONVB]; xm1 = sp[2 * CONVB]; }
            else if (half == 0 && sq == 0) { xm3 = 0.f; xm2 = 0.f; xm1 = 0.f; }
            else { const bf16_t* pp = QKVB + (size_t)(m0 + ts - 3) * CONVB + col; xm3 = bf2f(pp[0]); xm2 = bf2f(pp[CONVB]); xm1 = bf2f(pp[2 * CONVB]); }
            const bf16_t* px = QKVB + (size_t)(m0 + ts) * CONVB + col;
#pragma unroll
            for (int ib = 0; ib < 32; ib += 16) {
                bf16_t xin[16];
#pragma unroll
                for (int i = 0; i < 16; ++i) xin[i] = px[(size_t)(ib + i) * CONVB];
#pragma unroll
                for (int i = 0; i < 16; ++i) {
                    const int t = ts + ib + i;
                    const float x = bf2f(xin[i]);
                    const float y = fmaf(w0, xm3, fmaf(w1, xm2, fmaf(w2, xm1, w3 * x)));
                    *(LAS bf16_t*)(Qraw + t * 256 + ((((dq >> 3) ^ (t & 15))) << 4) + (dq & 7) * 2) = f2bf(y / (1.0f + expf(-y)));
                    xm3 = xm2; xm2 = xm1; xm1 = x;
                }
                asm volatile("" ::: "memory");
            }
        }
        __syncthreads();
        {
            const int row = tg >> 2, qt = tg & 3; float sk = 0.f, sq2 = 0.f;
#pragma unroll
            for (int c = 0; c < 4; ++c) {
                const int pc = ((4 * qt + c) ^ (row & 15)) << 4;
                const u32x4 a = *(const LAS u32x4*)(Kraw + row * 256 + pc), b = *(const LAS u32x4*)(Qraw + row * 256 + pc);
                const float ak[8] = {bflo(a.x), bfhi(a.x), bflo(a.y), bfhi(a.y), bflo(a.z), bfhi(a.z), bflo(a.w), bfhi(a.w)};
                const float bq[8] = {bflo(b.x), bfhi(b.x), bflo(b.y), bfhi(b.y), bflo(b.z), bfhi(b.z), bflo(b.w), bfhi(b.w)};
#pragma unroll
                for (int q = 0; q < 8; ++q) { sk += ak[q] * ak[q]; sq2 += bq[q] * bq[q]; }
            }
            sk += __shfl_xor(sk, 1); sk += __shfl_xor(sk, 2); sq2 += __shfl_xor(sq2, 1); sq2 += __shfl_xor(sq2, 2);
            if (qt == 0) { RK[row] = rsqrtf(sk + 1e-6f); RQ[row] = rsqrtf(sq2 + 1e-6f) * 0.08838834764831845f; }
        }
        __syncthreads();
        if (wg4 < 3) {
            const int ti = wg4 == 0 ? 0 : 1, tj = wg4 == 2 ? 1 : 0;
            const int ri = 32 * ti + r32, rj = 32 * tj + r32;
            f32x16 accK = {}, accQ = {};
#pragma unroll
            for (int ks = 0; ks < 8; ++ks) {
                const int ch = 2 * ks + hi;
                const bf16x8 ki = *(const LAS bf16x8*)(Kraw + ri * 256 + ((ch ^ (ri & 15)) << 4));
                const bf16x8 kj = *(const LAS bf16x8*)(Kraw + rj * 256 + ((ch ^ (rj & 15)) << 4));
                const bf16x8 qi = *(const LAS bf16x8*)(Qraw + ri * 256 + ((ch ^ (ri & 15)) << 4));
                accK = __builtin_amdgcn_mfma_f32_32x32x16_bf16(ki, kj, accK, 0, 0, 0);
                accQ = __builtin_amdgcn_mfma_f32_32x32x16_bf16(kj, qi, accQ, 0, 0, 0);
            }
            {
                const int j = rj; const float rkj = RK[j], gcj = GC[j];
#pragma unroll
                for (int r = 0; r < 16; ++r) {
                    const int i = 32 * ti + crow(r, hi);
                    const float v = i > j ? BETA[i] * RK[i] * rkj * accK[r] * expf(fminf(GC[i] - gcj, 0.f)) : 0.f;
                    Ml[i * 64 + j] = v;
                }
            }
            {
                const int i = ri; const float rqi = RQ[i], gci = GC[i];
                unsigned char* Ab = ublk + UB_A + i * RA;
#pragma unroll
                for (int g = 0; g < 4; ++g) {
                    float v[4];
#pragma unroll
                    for (int e = 0; e < 4; ++e) { const int j = 32 * tj + 8 * g + 4 * hi + e; v[e] = i >= j ? rqi * RK[j] * accQ[4 * g + e] * expf(fminf(gci - GC[j], 0.f)) : 0.f; }
                    u32x2 o; o.x = cvt_pk_bf16(v[0], v[1]); o.y = cvt_pk_bf16(v[2], v[3]);
                    *(u32x2*)(Ab + (4 * tj + g) * 16 + hi * 8) = o;
                }
            }
        } else {
            unsigned char* Ab = ublk + UB_A + r32 * RA;
#pragma unroll
            for (int g = 0; g < 4; ++g) { u32x2 o; o.x = 0u; o.y = 0u; *(u32x2*)(Ab + (4 + g) * 16 + hi * 8) = o; }
        }
        __syncthreads();
        if (wg4 >= 2) {
            const int dk = (wg4 - 2) * 64 + lane;
            unsigned char* kd = ublk + UB_KD + dk * RA;
#pragma unroll
            for (int c = 0; c < 8; ++c) {
                float v[8];
#pragma unroll
                for (int q = 0; q < 8; ++q) { const int t = 8 * c + q; v[q] = xr[t] * RK[t] * EKD[t]; }
                u32x4 o; o.x = cvt_pk_bf16(v[0], v[1]); o.y = cvt_pk_bf16(v[2], v[3]); o.z = cvt_pk_bf16(v[4], v[5]); o.w = cvt_pk_bf16(v[6], v[7]);
                *(u32x2*)(kd + c * 16) = u32x2{o.x, o.y}; *(u32x2*)(kd + c * 16 + 8) = u32x2{o.z, o.w};
            }
#pragma unroll
            for (int t = 0; t < 64; ++t) xr[t] *= RK[t] * BETA[t] * EG[t];
        } else {
#pragma unroll
            for (int t = 0; t < 64; ++t) xr[t] *= BETA[t];
        }
#pragma unroll
        for (int i = 1; i < 64; ++i) {
            const int mi = __float_as_int(Ml[i * 64 + lane]);
            float a0 = 0.f, a1 = 0.f;
#pragma unroll
            for (int j = 0; j < i; ++j) {
                const float mv = __int_as_float(__builtin_amdgcn_readlane(mi, j));
                if (j & 1) a1 = fmaf(mv, xr[j], a1); else a0 = fmaf(mv, xr[j], a0);
            }
            xr[i] -= (a0 + a1);
            asm volatile("" ::: "memory");
        }
        if (wg4 < 2) {
            bf16_t* U = (bf16_t*)(ublk + UB_U) + wg4 * 64 + lane;
#pragma unroll
            for (int t = 0; t < 64; ++t) U[t * 128] = f2bf(xr[t]);
        } else {
            const int dk = (wg4 - 2) * 64 + lane;
#pragma unroll
            for (int t = 0; t < 64; ++t) *(bf16_t*)(ublk + UB_W + t * RW + dk * 2) = f2bf(xr[t]);
        }
        {
            const int row = tg >> 2, qt = tg & 3; const float s = RQ[row] * EG[row];
#pragma unroll
            for (int c = 0; c < 4; ++c) {
                const int pc = ((4 * qt + c) ^ (row & 15)) << 4;
                const u32x4 b = *(const LAS u32x4*)(Qraw + row * 256 + pc);
                u32x4 o; o.x = cvt_pk_bf16(bflo(b.x) * s, bfhi(b.x) * s); o.y = cvt_pk_bf16(bflo(b.y) * s, bfhi(b.y) * s); o.z = cvt_pk_bf16(bflo(b.z) * s, bfhi(b.z) * s); o.w = cvt_pk_bf16(bflo(b.w) * s, bfhi(b.w) * s);
                { unsigned char* qp = ublk + UB_QG + row * RW + (4 * qt + c) * 16; *(u32x2*)qp = u32x2{o.x, o.y}; *(u32x2*)(qp + 8) = u32x2{o.z, o.w}; }
            }
        }
        __syncthreads();
    }
}
__device__ __forceinline__ bf16x8 pack_acc8(const f32x16& a, int s) {
    u32x4 w; w.x = cvt_pk_bf16(a[8 * s + 0], a[8 * s + 1]); w.y = cvt_pk_bf16(a[8 * s + 2], a[8 * s + 3]); w.z = cvt_pk_bf16(a[8 * s + 4], a[8 * s + 5]); w.w = cvt_pk_bf16(a[8 * s + 6], a[8 * s + 7]);
    return *reinterpret_cast<bf16x8*>(&w);
}
template <int ROWB> __device__ __forceinline__ bf16x8 ld_afrag(const LAS unsigned char* rowp, int k0) {
    const u32x2 a = *(const LAS u32x2*)(rowp + k0 * 2);
    const u32x2 b = *(const LAS u32x2*)(rowp + k0 * 2 + 16);
    u32x4 w; w.x = a.x; w.y = a.y; w.z = b.x; w.w = b.y; return *reinterpret_cast<bf16x8*>(&w);
}
__device__ __forceinline__ void d2_task(const Params& P, LAS unsigned char* lds, int sq0, int nsteps, int h) {
    const int tid = threadIdx.x, cw = __builtin_amdgcn_readfirstlane(tid >> 6), lane = tid & 63, r32 = lane & 31, hi = lane >> 5;
    const bool comp = cw < 4; const int d0 = 32 * cw;
    const bool isS = sq0 >= 256;
    const float* GL = (const float*)(P.ws + WS_GL);
    bf16_t* OB = (bf16_t*)(P.ws + WS_OB);
    f32x16 S[4];
#pragma unroll
    for (int t = 0; t < 4; ++t)
#pragma unroll
        for (int r = 0; r < 16; ++r) S[t][r] = (isS && comp) ? P.in[8][(((size_t)(sq0 - 256) * 16 + h) * 128 + 32 * t + crow(r, hi)) * 128 + d0 + r32] : 0.f;
    {
        const u32x4* src = (const u32x4*)unit_ptr(P, sq0 * 16 + h);
        for (int i = tid; i < UNITB / 16; i += 512) *(LAS u32x4*)(lds + (size_t)i * 16) = src[i];
    }
    __syncthreads();
    for (int n = 0; n < nsteps; ++n) {
        const int sq = sq0 + n, u = sq * 16 + h;
        const bool more = n + 1 < nsteps;
        if (!comp) {
            if (more) {
                const u32x4* src = (const u32x4*)unit_ptr(P, u + 16);
                LAS unsigned char* dst = lds + ((n + 1) & 1) * UNITB;
                const int lt = tid - 256;
                u32x4 pre[19];
#pragma unroll
                for (int i = 0; i < 19; ++i) if (lt + 256 * i < UNITB / 16) pre[i] = src[lt + 256 * i];
#pragma unroll
                for (int i = 0; i < 19; ++i) if (lt + 256 * i < UNITB / 16) *(LAS u32x4*)(dst + (size_t)(lt + 256 * i) * 16) = pre[i];
            }
        } else {
            int lo = lane; asm volatile("" : "+v"(lo));
            const int r32 = lo & 31, hi = lo >> 5;
            const LAS unsigned char* blk = lds + (n & 1) * UNITB;
            const LAS unsigned char* Wi = blk + UB_W + r32 * RW + 8 * hi; const LAS unsigned char* QGi = blk + UB_QG + r32 * RW + 8 * hi;
            const LAS unsigned char* Ai = blk + UB_A + r32 * RA + 8 * hi; const LAS unsigned char* KDi = blk + UB_KD + r32 * RA + 8 * hi;
            const LAS bf16_t* Ui = (const LAS bf16_t*)(blk + UB_U);
            const float gl = GL[u];
            const int m0 = sq < 256 ? 64 * sq : SEQ + 64 * (sq - 256);
            bf16x8 Sb[4][2];
#pragma unroll
            for (int t = 0; t < 4; ++t) { Sb[t][0] = pack_acc8(S[t], 0); Sb[t][1] = pack_acc8(S[t], 1); }
            f32x16 aW[2];
#pragma unroll
            for (int ct = 0; ct < 2; ++ct) {
                aW[ct] = f32x16{};
#pragma unroll
                for (int t = 0; t < 4; ++t)
#pragma unroll
                    for (int s = 0; s < 2; ++s)
                        aW[ct] = __builtin_amdgcn_mfma_f32_32x32x16_bf16(ld_afrag<RW>(Wi + 32 * ct * RW, 32 * t + 16 * s), Sb[t][s], aW[ct], 0, 0, 0);
            }
            bf16x8 Vb[2][2];
#pragma unroll
            for (int ct = 0; ct < 2; ++ct) {
#pragma unroll
                for (int r = 0; r < 16; ++r) aW[ct][r] = bf2f(Ui[(32 * ct + crow(r, hi)) * 128 + d0 + r32]) - aW[ct][r];
                Vb[ct][0] = pack_acc8(aW[ct], 0); Vb[ct][1] = pack_acc8(aW[ct], 1);
            }
#pragma unroll
            for (int co = 0; co < 2; ++co) {
                f32x16 aQ = f32x16{};
#pragma unroll
                for (int t = 0; t < 4; ++t)
#pragma unroll
                    for (int s = 0; s < 2; ++s)
                        aQ = __builtin_amdgcn_mfma_f32_32x32x16_bf16(ld_afrag<RW>(QGi + 32 * co * RW, 32 * t + 16 * s), Sb[t][s], aQ, 0, 0, 0);
#pragma unroll
                for (int ct = 0; ct <= co; ++ct)
#pragma unroll
                    for (int s = 0; s < 2; ++s)
                        aQ = __builtin_amdgcn_mfma_f32_32x32x16_bf16(ld_afrag<RA>(Ai + 32 * co * RA, 32 * ct + 16 * s), Vb[ct][s], aQ, 0, 0, 0);
#pragma unroll
                for (int r = 0; r < 16; ++r) OB[(size_t)(m0 + 32 * co + crow(r, hi)) * DM + h * 128 + d0 + r32] = f2bf(aQ[r]);
            }
#pragma unroll
            for (int t = 0; t < 4; ++t) {
                f32x16 acc = S[t] * gl;
#pragma unroll
                for (int ct = 0; ct < 2; ++ct)
#pragma unroll
                    for (int s = 0; s < 2; ++s)
                        acc = __builtin_amdgcn_mfma_f32_32x32x16_bf16(ld_afrag<RA>(KDi + 32 * t * RA, 32 * ct + 16 * s), Vb[ct][s], acc, 0, 0, 0);
                S[t] = acc;
            }
        }
        __syncthreads();
    }
    if (comp) {
        const int sl = sq0 + nsteps - 1;
        float* dst = P.out + (isS ? O_DS + ((size_t)(sl - 256) * 16 + h) * 16384 : O_DP + (size_t)h * 16384);
#pragma unroll
        for (int t = 0; t < 4; ++t)
#pragma unroll
            for (int r = 0; r < 16; ++r) dst[(size_t)(32 * t + crow(r, hi)) * 128 + d0 + r32] = S[t][r];
    }
}
__device__ __forceinline__ void d2_phase(const Params& P, LAS unsigned char* lds) {
    const int G = gridDim.x, bx = blockIdx.x;
    for (int k = 0;; ++k) {
        int sq0, nst, h;
        if (G <= 16) { const int T = bx + k * G; if (T >= 528) break; if (T < 16) { sq0 = 0; nst = 256; h = T; } else { sq0 = 256 + ((T - 16) >> 4); nst = 1; h = (T - 16) & 15; } }
        else if (bx < 16) { if (k > 0) break; sq0 = 0; nst = 256; h = bx; }
        else { const int i = bx - 16 + k * (G - 16); if (i >= 512) break; sq0 = 256 + (i >> 4); nst = 1; h = i & 15; }
        d2_task(P, lds, sq0, nst, h);
    }
}
constexpr int IX_QROW = 144;
constexpr int IX_HIST = 36864, IX_SM = IX_HIST + 65536;
__device__ __forceinline__ unsigned lds_add(LAS unsigned* p, unsigned v) { return __hip_atomic_fetch_add(p, v, __ATOMIC_RELAXED, __HIP_MEMORY_SCOPE_WORKGROUP); }
__device__ __forceinline__ void lds_or(LAS unsigned* p, unsigned v) { (void)__hip_atomic_fetch_or(p, v, __ATOMIC_RELAXED, __HIP_MEMORY_SCOPE_WORKGROUP); }
__device__ __forceinline__ float relu_(float x) { return fmaxf(x, 0.f); }
__device__ __forceinline__ unsigned ord_key(float x) { const unsigned u = __float_as_uint(x); return (u & 0x80000000u) ? ~u : (u | 0x80000000u); }

__device__ __forceinline__ void ix_pass(const int PASS, LAS unsigned char* lds, const bf16_t* KI, int n32, const float (&wv)[8], int w, int lane) {
    const int r32 = lane & 31, hi = lane >> 5, q = lane & 15, hp = (lane >> 4) & 1;
    LAS unsigned* hist = (LAS unsigned*)(lds + IX_HIST) + q * 1024;
    LAS unsigned* sm = (LAS unsigned*)(lds + IX_SM);
    const unsigned prefix = sm[q]; const unsigned rem = sm[16 + q];
    for (int pi = w; pi < (n32 >> 1); pi += 8) {
        bf16x8 A0[4], A1[4];
        const bf16_t* kp = KI + (size_t)(64 * pi + r32) * 64 + 8 * hi;
#pragma unroll
        for (int kk = 0; kk < 4; ++kk) { A0[kk] = *(const bf16x8*)(kp + 16 * kk); A1[kk] = *(const bf16x8*)(kp + 32 * 64 + 16 * kk); }
        f32x16 S0 = {}, S1 = {};
#pragma unroll
        for (int hh = 0; hh < 8; ++hh) {
            f32x16 a0 = {}, a1 = {};
#pragma unroll
            for (int kk = 0; kk < 4; ++kk) {
                const bf16x8 B = *(const LAS bf16x8*)(lds + ((2 * hh + hp) * 16 + q) * IX_QROW + (2 * kk + hi) * 16);
                a0 = __builtin_amdgcn_mfma_f32_32x32x16_bf16(A0[kk], B, a0, 0, 0, 0);
                a1 = __builtin_amdgcn_mfma_f32_32x32x16_bf16(A1[kk], B, a1, 0, 0, 0);
            }
#pragma unroll
            for (int r = 0; r < 16; ++r) { S0[r] = fmaf(relu_(a0[r]), wv[hh], S0[r]); S1[r] = fmaf(relu_(a1[r]), wv[hh], S1[r]); }
#pragma unroll
            for (int r = 0; r < 16; ++r) { asm volatile("" : "+v"(S0[r])); asm volatile("" : "+v"(S1[r])); }
        }
        unsigned bits0 = 0u, bits1 = 0u;
#pragma unroll
        for (int r = 0; r < 8; ++r) {
            const float mine0 = hp ? S0[8 + r] : S0[r], give0 = hp ? S0[r] : S0[8 + r];
            const float mine1 = hp ? S1[8 + r] : S1[r], give1 = hp ? S1[r] : S1[8 + r];
            const float s0 = mine0 + __shfl_xor(give0, 16), s1 = mine1 + __shfl_xor(give1, 16);
            const unsigned k0 = ord_key(s0), k1 = ord_key(s1);
            const int rowbit = (r & 3) + 8 * (r >> 2) + 16 * hp + 4 * hi;
            if (PASS == 0) {
                const unsigned b0 = k0 >> 21, b1 = k1 >> 21;
                lds_add(&hist[b0 >> 1], 1u << (16 * (b0 & 1))); lds_add(&hist[b1 >> 1], 1u << (16 * (b1 & 1)));
            } else if (PASS == 1) {
                const unsigned b0 = (k0 >> 10) & 2047u, b1 = (k1 >> 10) & 2047u;
                if ((k0 >> 21) == prefix) lds_add(&hist[b0 >> 1], 1u << (16 * (b0 & 1)));
                if ((k1 >> 21) == prefix) lds_add(&hist[b1 >> 1], 1u << (16 * (b1 & 1)));
            } else if (PASS == 2) {
                const unsigned b0 = k0 & 1023u, b1 = k1 & 1023u;
                if ((k0 >> 10) == prefix) lds_add(&hist[b0 >> 1], 1u << (16 * (b0 & 1)));
                if ((k1 >> 10) == prefix) lds_add(&hist[b1 >> 1], 1u << (16 * (b1 & 1)));
            } else {
                bool sel0 = k0 > prefix, sel1 = k1 > prefix;
                if (k0 == prefix) sel0 = lds_add(&sm[32 + q], 1u) < rem;
                if (k1 == prefix) sel1 = lds_add(&sm[32 + q], 1u) < rem;
                bits0 |= sel0 ? (1u << rowbit) : 0u; bits1 |= sel1 ? (1u << rowbit) : 0u;
            }
        }
        if (PASS == 3) { lds_or(&hist[(2 * pi) - q * 512], bits0); lds_or(&hist[(2 * pi + 1) - q * 512], bits1); }
    }
}
__device__ __forceinline__ void ix_select(const int NBITS, LAS unsigned char* lds, int w, int lane) {
    const int WPL = (1 << NBITS) / 128;
    LAS unsigned* sm = (LAS unsigned*)(lds + IX_SM);
#pragma unroll 1
    for (int qq = 0; qq < 2; ++qq) {
        const int q = 2 * w + qq;
        LAS unsigned* hist = (LAS unsigned*)(lds + IX_HIST) + q * 1024 + lane * WPL;
        unsigned ls = 0;
#pragma unroll 1
        for (int i = 0; i < WPL; ++i) { const unsigned v = hist[i]; ls += (v & 0xffffu) + (v >> 16); }
        unsigned suf = ls;
#pragma unroll
        for (int off = 1; off < 64; off <<= 1) { const unsigned v = __shfl_down(suf, off); if (lane + off < 64) suf += v; }
        const unsigned rem = sm[16 + q]; const unsigned above = suf - ls;
        if (above < rem && rem <= suf) {
            unsigned c = above; int d = 0; unsigned nrem = rem;
            bool found = false;
#pragma unroll 1
            for (int i = WPL - 1; i >= 0 && !found; --i) {
                const unsigned v = hist[i]; const unsigned chi = v >> 16, clo = v & 0xffffu;
                if (c + chi >= rem) { d = (lane * WPL + i) * 2 + 1; nrem = rem - c; found = true; }
                else { c += chi; if (c + clo >= rem) { d = (lane * WPL + i) * 2; nrem = rem - c; found = true; } else c += clo; }
            }
            sm[q] = (sm[q] << NBITS) | (unsigned)d; sm[16 + q] = nrem;
        }
    }
}
__device__ __forceinline__ void ix_unit(const Params& P, LAS unsigned char* lds, bool isS, int idx) {
    const int tid = threadIdx.x, w = __builtin_amdgcn_readfirstlane(tid >> 6), lane = tid & 63;
    int m0, n32, nwords, mstride; const bf16_t* KI; unsigned* MK;
    if (!isS) { m0 = idx * 16; n32 = 2 * ((idx >> 2) + 1); nwords = 8 * ((idx >> 4) + 1); mstride = 512; KI = (const bf16_t*)(P.ws + WS_KIP); MK = (unsigned*)(P.ws + WS_MASKP) + (size_t)m0 * 512; }
    else { const int b = idx >> 2; m0 = SEQ + idx * 16; n32 = 34; nwords = 36; mstride = 36; KI = (const bf16_t*)(P.ws + WS_KIS) + (size_t)b * LS * 64; MK = (unsigned*)(P.ws + WS_MASKS) + (size_t)(idx * 16) * 36; }
    if (n32 <= 8) {
        for (int i = tid; i < 16 * nwords; i += NTHREADS) { const int q = i / nwords, wd = i % nwords; MK[(size_t)q * mstride + wd] = wd < n32 ? 0xffffffffu : 0u; }
        return;
    }
    __syncthreads();
    {
        const bf16_t* QI = (const bf16_t*)(P.ws + WS_QI) + (size_t)m0 * 1024;
#pragma unroll
        for (int i = 0; i < 4; ++i) {
            const int cid = tid + 512 * i, q = cid >> 7, hc = cid & 127, h = hc >> 3, ch = hc & 7;
            *(LAS u32x4*)(lds + (h * 16 + q) * IX_QROW + ch * 16) = *(const u32x4*)(QI + (size_t)q * 1024 + h * 64 + ch * 8);
        }
    }
    float wv[8];
    {
        const float* WI = (const float*)(P.ws + WS_WI) + (size_t)(m0 + (lane & 15)) * 16 + ((lane >> 4) & 1);
#pragma unroll
        for (int hh = 0; hh < 8; ++hh) wv[hh] = WI[2 * hh];
    }
    LAS unsigned* sm = (LAS unsigned*)(lds + IX_SM);
    if (tid < 16) { sm[tid] = 0u; sm[16 + tid] = 256u; sm[32 + tid] = 0u; }
#pragma unroll 1
    for (int pass = 0; pass < 4; ++pass) {
#pragma unroll
        for (int i = 0; i < 8; ++i) *(LAS u32x4*)(lds + IX_HIST + (size_t)(tid + 512 * i) * 16) = u32x4{0u, 0u, 0u, 0u};
        __syncthreads();
        ix_pass(pass, lds, KI, n32, wv, w, lane);
        __syncthreads();
        if (pass < 3) ix_select(pass == 2 ? 10 : 11, lds, w, lane);
        __syncthreads();
    }
    __syncthreads();
    for (int i = tid; i < 16 * nwords; i += NTHREADS) { const int q = i / nwords, wd = i % nwords; MK[(size_t)q * mstride + wd] = ((const LAS unsigned*)(lds + IX_HIST))[q * 512 + wd]; }
}
__device__ __forceinline__ void indexer_phase(const Params& P, LAS unsigned char* lds) {
    const int G = gridDim.x, bx = blockIdx.x;
    const int rp = (1024 + G - 1) / G, rs = (128 + G - 1) / G;
#pragma unroll 1
    for (int r = 0; r < rp + rs; ++r) {
        bool isS; int idx;
        if (r < rp) { const int qt = (r & 1) ? r * G + (G - 1 - bx) : r * G + bx; if (qt >= 1024) continue; isS = false; idx = 1023 - qt; }
        else { const int i = (r - rp) * G + bx; if (i >= 128) continue; isS = true; idx = i; }
        ix_unit(P, lds, isS, idx);
    }
}
namespace att {
constexpr int D = 128, QBLK = 32, KVBLK = 64;
constexpr float SCALE = 0.088388347648318440f;
constexpr float THR = 8.f;
constexpr size_t SHM_V = KVBLK * D * 2, SHM_K = KVBLK * D * 2, SHM_ATTN = 2 * SHM_V + 2 * SHM_K + 8 * 64 * 4;
constexpr int QL_OFF = (int)SHM_ATTN, LUT_OFF = QL_OFF + 8 * 32 * 256;
using f32x8 = __attribute__((ext_vector_type(8))) float;
#define KSWZ(row, colB) ((row) * 256 + ((colB) ^ (((row) & 7) << 4)))
#define SBAR() __builtin_amdgcn_sched_barrier(0)
template <typename TIn> struct Stage;
template <> struct Stage<bf16_t> { using T = bf16x8;
  __device__ static __forceinline__ T ld8(const bf16_t* p) { return *reinterpret_cast<const bf16x8*>(p); }
  __device__ static __forceinline__ bf16x8 tobf(T x) { return x; } };
template <> struct Stage<float> { using T = f32x8;
  __device__ static __forceinline__ T ld8(const float* p) { return *reinterpret_cast<const f32x8*>(p); }
  __device__ static __forceinline__ bf16x8 tobf(T x) {
    u32x4 w = {cvt_pk_bf16(x[0], x[1]), cvt_pk_bf16(x[2], x[3]), cvt_pk_bf16(x[4], x[5]), cvt_pk_bf16(x[6], x[7])}; return *reinterpret_cast<bf16x8*>(&w); } };

__device__ __forceinline__ void partialSM(f32x16& p0, f32x16& p1, float& m_reg, float& mn, float& alpha) {
  constexpr float C = SCALE * 1.4426950408889634f;
  float pmax = p0[0]; for (int r = 1; r < 16; ++r) pmax = fmaxf(pmax, p0[r]); for (int r = 0; r < 16; ++r) pmax = fmaxf(pmax, p1[r]);
  { auto rr = __builtin_amdgcn_permlane32_swap(__float_as_uint(pmax), __float_as_uint(pmax), false, false);
    pmax = fmaxf(__uint_as_float(rr[0]), __uint_as_float(rr[1])); }
  if (__builtin_expect(__all(pmax - m_reg <= THR / SCALE), 1)) { mn = m_reg; alpha = 1.f; }
  else { mn = fmaxf(m_reg, pmax); alpha = __builtin_amdgcn_exp2f((m_reg - mn) * C); m_reg = mn; }
  float mnC = -mn * C;
  for (int r = 0; r < 16; ++r) p0[r] = fmaf(p0[r], C, mnC); for (int r = 0; r < 16; ++r) p1[r] = fmaf(p1[r], C, mnC);
  for (int r = 0; r < 16; ++r) p0[r] = __builtin_amdgcn_exp2f(p0[r]);
}
__device__ __forceinline__ void finishSM(f32x16& p0, f32x16& p1, float alpha, float& l_reg, bf16x8& pa0, bf16x8& pa1, bf16x8& pa2, bf16x8& pa3) {
  for (int r = 0; r < 16; ++r) p1[r] = __builtin_amdgcn_exp2f(p1[r]);
  float ps = 0; for (int r = 0; r < 16; ++r) ps += p0[r]; for (int r = 0; r < 16; ++r) ps += p1[r];
  { auto rr = __builtin_amdgcn_permlane32_swap(__float_as_uint(ps), __float_as_uint(ps), false, false);
    ps = __uint_as_float(rr[0]) + __uint_as_float(rr[1]); }
  l_reg = l_reg * alpha + ps;
#define PK4(P, BASE, OUT) do { unsigned a0 = cvt_pk_bf16(P[BASE + 0], P[BASE + 1]), a1 = cvt_pk_bf16(P[BASE + 2], P[BASE + 3]);   \
    unsigned b0 = cvt_pk_bf16(P[BASE + 4], P[BASE + 5]), b1 = cvt_pk_bf16(P[BASE + 6], P[BASE + 7]);                              \
    auto r0 = __builtin_amdgcn_permlane32_swap(a0, b0, false, false); auto r1 = __builtin_amdgcn_permlane32_swap(a1, b1, false, false); \
    u32x4 w = {r0[0], r1[0], r0[1], r1[1]}; OUT = *reinterpret_cast<bf16x8*>(&w); } while (0)
  PK4(p0, 0, pa0); PK4(p0, 8, pa1); PK4(p1, 0, pa2); PK4(p1, 8, pa3);
#undef PK4
}
__device__ __forceinline__ void qkt(f32x16& p0, f32x16& p1, const LAS char* Ks, const LAS char* Qs, int r32, int hi) {
  p0 = f32x16{}; p1 = f32x16{};
  for (int d0 = 0; d0 < 8; ++d0) { int cb = (d0 * 16 + hi * 8) * 2;
    bf16x8 b0 = *reinterpret_cast<const LAS bf16x8*>(Ks + KSWZ(r32, cb));
    bf16x8 b1 = *reinterpret_cast<const LAS bf16x8*>(Ks + KSWZ(32 + r32, cb));
    bf16x8 qf = *reinterpret_cast<const LAS bf16x8*>(Qs + KSWZ(r32, cb));
    p0 = __builtin_amdgcn_mfma_f32_32x32x16_bf16(b0, qf, p0, 0, 0, 0);
    p1 = __builtin_amdgcn_mfma_f32_32x32x16_bf16(b1, qf, p1, 0, 0, 0); }
}
__device__ __forceinline__ int v_st(int k, int c) { const int kk = (k & ~0xC) | ((k & 4) << 1) | ((k & 8) >> 1); return ((kk >> 3) * 4 + (c >> 5)) * 512 + ((kk & 7) * 32 + (c & 31)) * 2; }
__device__ __forceinline__ int v_rd_base(int lane) { return ((lane & 3) << 3) | (((lane >> 2) & 3) << 6) | (((lane >> 4) & 1) << 5) | (((lane >> 5) & 1) << 8); }
constexpr int v_rd_off(int d0, int ks, int half) { return d0 * 512 + ks * 4096 + half * 2048; }
template <int OFF> __device__ __forceinline__ s16x4 tr_read(int vb) {
  s16x4 r; asm volatile("ds_read_b64_tr_b16 %0, %1 offset:%2" : "=&v"(r) : "v"(vb), "i"(OFF) : "memory"); return r;
}
template <int D0> __device__ __forceinline__ void pv_one(f32x16& od, int vb, bf16x8 pa0, bf16x8 pa1, bf16x8 pa2, bf16x8 pa3) {
  const s16x4 l0 = tr_read<v_rd_off(D0, 0, 0)>(vb), h0 = tr_read<v_rd_off(D0, 0, 1)>(vb), l1 = tr_read<v_rd_off(D0, 1, 0)>(vb), h1 = tr_read<v_rd_off(D0, 1, 1)>(vb);
  const s16x4 l2 = tr_read<v_rd_off(D0, 2, 0)>(vb), h2 = tr_read<v_rd_off(D0, 2, 1)>(vb), l3 = tr_read<v_rd_off(D0, 3, 0)>(vb), h3 = tr_read<v_rd_off(D0, 3, 1)>(vb);
  asm volatile("s_waitcnt lgkmcnt(0)" ::: "memory"); SBAR();
#define PK(L, H) (bf16x8){L[0], L[1], L[2], L[3], H[0], H[1], H[2], H[3]}
  od = __builtin_amdgcn_mfma_f32_32x32x16_bf16(pa0, PK(l0, h0), od, 0, 0, 0);
  od = __builtin_amdgcn_mfma_f32_32x32x16_bf16(pa1, PK(l1, h1), od, 0, 0, 0);
  od = __builtin_amdgcn_mfma_f32_32x32x16_bf16(pa2, PK(l2, h2), od, 0, 0, 0);
  od = __builtin_amdgcn_mfma_f32_32x32x16_bf16(pa3, PK(l3, h3), od, 0, 0, 0);
#undef PK
}
__device__ __forceinline__ void pv_d0(f32x16* o, int vb, bf16x8 pa0, bf16x8 pa1, bf16x8 pa2, bf16x8 pa3) {
  pv_one<0>(o[0], vb, pa0, pa1, pa2, pa3); pv_one<1>(o[1], vb, pa0, pa1, pa2, pa3); pv_one<2>(o[2], vb, pa0, pa1, pa2, pa3); pv_one<3>(o[3], vb, pa0, pa1, pa2, pa3);
}
__device__ __forceinline__ void mask_bias(f32x16& p0, f32x16& p1, unsigned long long mw, int hi, bool far, float cfar, const LAS float* lut, int relb) {
  const unsigned lo = (unsigned)mw >> (4 * hi), hw = (unsigned)(mw >> 32) >> (4 * hi);
  const float ninf = -__builtin_inff();
  if (far) {
#pragma unroll
    for (int r = 0; r < 16; ++r) { const int bit = (r & 3) + 8 * (r >> 2);
      p0[r] = ((lo >> bit) & 1u) ? p0[r] + cfar : ninf; p1[r] = ((hw >> bit) & 1u) ? p1[r] + cfar : ninf; }
  } else {
    const int rb = relb + 4 * hi;
#pragma unroll
    for (int r = 0; r < 16; ++r) { const int bit = (r & 3) + 8 * (r >> 2);
      const int i0 = min(max(rb + bit, 0), 191), i1 = min(max(rb + 32 + bit, 0), 191);
      p0[r] = ((lo >> bit) & 1u) ? p0[r] + lut[i0] : ninf; p1[r] = ((hw >> bit) & 1u) ? p1[r] + lut[i1] : ninf;
      asm volatile("" : "+v"(p0[r]), "+v"(p1[r])); }
  }
}
struct KVSrc { const void* k0; const void* v0; const void* k1; const void* v1; int splitT; };

template <typename TKV, int SDEPTH>
__device__ __forceinline__ void attn_unit(const bf16_t* __restrict__ Qb, const KVSrc kv, bf16_t* __restrict__ Ob, int NT, const unsigned long long* __restrict__ maskb, int mstride,
                                          int qpos0, int nvalid, LAS char* lds, const int tid) {
  using St = Stage<TKV>;
  const int wid = __builtin_amdgcn_readfirstlane(tid >> 6), lane = tid & 63, r32 = lane & 31, hi = lane >> 5;
  LAS char* V_lds = lds; LAS char* K_lds = lds + 2 * SHM_V;
  LAS float* wsl = (LAS float*)(lds + 2 * SHM_V + 2 * SHM_K) + wid * 64; LAS float* li_l = wsl; LAS float* al_l = wsl + 32;
  const LAS float* lut = (const LAS float*)(lds + LUT_OFF);
  float m_reg = -1e30f, l_reg = 0; f32x16 o[4] = {};
  LAS char* qr = lds + QL_OFF + wid * 8192;
  const int wrow = (wid * QBLK < nvalid) ? wid * QBLK : (wid * QBLK) % nvalid;
  const bool wvalid = wid * QBLK < nvalid;
  const bf16_t* Qw = Qb + (size_t)(wrow + r32) * DM + hi * 8;
#pragma unroll
  for (int d0 = 0; d0 < 8; ++d0) *reinterpret_cast<LAS bf16x8*>(qr + KSWZ(r32, (d0 * 16 + hi * 8) * 2)) = *reinterpret_cast<const bf16x8*>(Qw + d0 * 16);
  const unsigned moff = (unsigned)((wrow + r32) * mstride);
  const int qpos = qpos0 + wrow + r32, qposw = qpos0 + wrow;
  const float cfar = lut[0];
  const int sr = tid >> 4, sc = (tid & 15) * 8, vst0 = v_st(sr, sc), vst1 = v_st(32 + sr, sc);
  const int vb0 = (int)(uintptr_t)V_lds + v_rd_base(lane);
  const int lofs = sr * DM + sc;
  struct { typename St::T vs0, vs1, ks0, ks1; } sr_[SDEPTH];
#define SLOAD(i, k0_) do { const int jt_ = (k0_) >> 6; const bool fst_ = jt_ < kv.splitT; \
    const TKV* kb_ = (fst_ ? (const TKV*)kv.k0 + (size_t)jt_ * 64 * DM : (const TKV*)kv.k1) + lofs; const TKV* vb_ = (fst_ ? (const TKV*)kv.v0 + (size_t)jt_ * 64 * DM : (const TKV*)kv.v1) + lofs; \
    sr_[i].vs0 = St::ld8(vb_); sr_[i].vs1 = St::ld8(vb_ + 32 * DM); sr_[i].ks0 = St::ld8(kb_); sr_[i].ks1 = St::ld8(kb_ + 32 * DM); } while (0)
#define SWRITE(b, i) do { *(LAS bf16x8*)(V_lds + (b) * SHM_V + vst0) = St::tobf(sr_[i].vs0);          \
    *(LAS bf16x8*)(V_lds + (b) * SHM_V + vst1) = St::tobf(sr_[i].vs1); int kc = sc * 2;               \
    *(LAS bf16x8*)(K_lds + (b) * SHM_K + KSWZ(sr, kc)) = St::tobf(sr_[i].ks0);                       \
    *(LAS bf16x8*)(K_lds + (b) * SHM_K + KSWZ(32 + sr, kc)) = St::tobf(sr_[i].ks1); } while (0)
#define SWAIT() do { if constexpr (SDEPTH == 2) asm volatile("s_waitcnt vmcnt(4)" ::: "memory"); else asm volatile("s_waitcnt vmcnt(0)" ::: "memory"); } while (0)
#define RESC(a) do { if (__any((a) < 1.f)) { if (hi == 0) al_l[r32] = (a); asm volatile("s_waitcnt lgkmcnt(0)" ::: "memory"); \
    for (int d = 0; d < 4; ++d) for (int r = 0; r < 16; ++r) o[d][r] *= al_l[crow(r, hi)]; } } while (0)
#define MB(P0, P1, j) do { const unsigned long long mw_ = maskb[moff + (unsigned)(j)]; mask_bias(P0, P1, mw_, hi, 64 * (j) + 191 <= qposw, cfar, lut, 64 * (j) - qpos + 128); } while (0)
  f32x16 pA0, pA1, pB0, pB1; float mnA, mnB, alA, alB; bf16x8 pa0, pa1, pa2, pa3;
  constexpr int SE = 0, SO = SDEPTH - 1;
  SLOAD(SE, 0); asm volatile("s_waitcnt vmcnt(0)" ::: "memory"); SWRITE(0, SE); __syncthreads();
  qkt(pA0, pA1, K_lds, qr, r32, hi); MB(pA0, pA1, 0); partialSM(pA0, pA1, m_reg, mnA, alA);
  SLOAD(SO, KVBLK); if constexpr (SDEPTH == 2) { if (2 < NT) SLOAD(SE, 2 * KVBLK); }
  SWAIT(); SWRITE(1, SO); __syncthreads();
  for (int j = 1; j + 1 < NT; j += 2) {
    SBAR(); qkt(pB0, pB1, K_lds + SHM_K, qr, r32, hi); MB(pB0, pB1, j);
    finishSM(pA0, pA1, alA, l_reg, pa0, pa1, pa2, pa3); SBAR();
    SLOAD(SO, (j + SDEPTH) * KVBLK); SBAR();
    pv_d0(o, vb0, pa0, pa1, pa2, pa3); partialSM(pB0, pB1, m_reg, mnB, alB);
    __syncthreads(); SWAIT(); SWRITE(0, SE);
    RESC(alB); __syncthreads();
    SBAR(); qkt(pA0, pA1, K_lds, qr, r32, hi); MB(pA0, pA1, j + 1);
    finishSM(pB0, pB1, alB, l_reg, pa0, pa1, pa2, pa3); SBAR();
    if (SDEPTH == 1 || j + 3 < NT) SLOAD(SE, (j + 1 + SDEPTH) * KVBLK); SBAR();
    pv_d0(o, vb0 + (int)SHM_V, pa0, pa1, pa2, pa3); partialSM(pA0, pA1, m_reg, mnA, alA);
    __syncthreads(); SWAIT(); SWRITE(1, SO);
    RESC(alA); __syncthreads();
  }
  SBAR(); qkt(pB0, pB1, K_lds + SHM_K, qr, r32, hi); MB(pB0, pB1, NT - 1);
  finishSM(pA0, pA1, alA, l_reg, pa0, pa1, pa2, pa3); SBAR();
  pv_d0(o, vb0, pa0, pa1, pa2, pa3); partialSM(pB0, pB1, m_reg, mnB, alB);
  __syncthreads(); RESC(alB);
  finishSM(pB0, pB1, alB, l_reg, pa0, pa1, pa2, pa3); SBAR();
  pv_d0(o, vb0 + (int)SHM_V, pa0, pa1, pa2, pa3);
  if (hi == 0) li_l[r32] = l_reg; asm volatile("s_waitcnt lgkmcnt(0)" ::: "memory");
  float rli[16];
#pragma unroll
  for (int r = 0; r < 16; ++r) rli[r] = __builtin_amdgcn_rcpf(li_l[crow(r, hi)]);
  if (wvalid) {
    int lo_ = lane; asm volatile("" : "+v"(lo_));
    const int r32o = lo_ & 31, hio = lo_ >> 5;
    bf16_t* Ow = Ob + (size_t)(wid * QBLK) * DM + r32o;
#pragma unroll
    for (int r = 0; r < 16; ++r) { const int orow = crow(r, hio);
      for (int d0 = 0; d0 < 4; ++d0) Ow[(size_t)orow * DM + d0 * 32] = f2bf(o[d0][r] * rli[r]); }
  }
  __syncthreads();
#undef SLOAD
#undef SWRITE
#undef SWAIT
#undef RESC
#undef MB
}
#undef KSWZ
#undef SBAR
}

__device__ __forceinline__ int t5_bucket(int rel) {
    const int n = rel < 0 ? -rel : rel;
    const int lg = n < 8 ? n : (n < 12 ? 8 : (n < 16 ? 9 : (n < 23 ? 10 : (n < 32 ? 11 : (n < 46 ? 12 : (n < 64 ? 13 : (n < 91 ? 14 : 15)))))));
    return (rel > 0 ? 16 : 0) + lg;
}
__device__ __forceinline__ void attn_phase(const Params& P, LAS unsigned char* lds) {
    const int G = gridDim.x, bx = blockIdx.x;
    bf16_t* Q = (bf16_t*)(P.ws + WS_Q);
    LAS float* lut = (LAS float*)(lds + att::LUT_OFF);
#pragma unroll 1
    for (int r = 0; r * G < 1024; ++r) {
        const int t = (r & 1) ? r * G + (G - 1 - bx) : r * G + bx; if (t >= 1024) continue;
        const int idx = 1023 - t, h = idx & 15, blk = idx >> 4;
        int tid = threadIdx.x; asm volatile("" : "+v"(tid));
        __syncthreads();
        if (tid < 192) lut[tid] = P.in[10][t5_bucket(tid - 128) * 16 + h] * (1.0f / att::SCALE);
        __syncthreads();
        att::KVSrc kv{(const bf16_t*)(P.ws + WS_KP) + h * 128, (const bf16_t*)(P.ws + WS_VP) + h * 128, nullptr, nullptr, 1 << 30};
        att::attn_unit<bf16_t, 1>(Q + (size_t)(256 * blk) * DM + h * 128, kv, Q + (size_t)(256 * blk) * DM + h * 128, 4 * (blk + 1),
                                  (const unsigned long long*)(P.ws + WS_MASKP) + (size_t)(256 * blk) * 256, 256, 256 * blk, 256, (LAS char*)lds, tid);
    }
#pragma unroll 1
    for (int i = bx; i < 512; i += G) {
        const int h = i & 15, blk = i >> 4;
        int tid = threadIdx.x; asm volatile("" : "+v"(tid));
        __syncthreads();
        if (tid < 192) lut[tid] = P.in[10][t5_bucket(tid - 128) * 16 + h] * (1.0f / att::SCALE);
        __syncthreads();
        att::KVSrc kv{P.in[4] + (size_t)blk * PAST * DM + h * 128, P.in[5] + (size_t)blk * PAST * DM + h * 128,
                      P.out + O_KS + (size_t)blk * TS * DM + h * 128, P.out + O_VS + (size_t)blk * TS * DM + h * 128, PAST / 64};
        att::attn_unit<float, 1>(Q + (size_t)(SEQ + 64 * blk) * DM + h * 128, kv, Q + (size_t)(SEQ + 64 * blk) * DM + h * 128, 18,
                                 (const unsigned long long*)(P.ws + WS_MASKS) + (size_t)(64 * blk) * 18, 18, PAST, 64, (LAS char*)lds, tid);
    }
}
#ifndef MK_MODE
#define MK_MODE 0
#endif
constexpr int NPHASE = 14;
template <int LO, int HI> __global__ void __launch_bounds__(NTHREADS, 2) hybrid_fwd(const Params PK) {
    const Params& P = PK;
    extern __shared__ __attribute__((aligned(16))) unsigned char lds_raw[];
    LAS unsigned char* lds = (LAS unsigned char*)lds_raw;
    volatile LAS unsigned* st = (volatile LAS unsigned*)(lds + MISC_OFF);
    if (threadIdx.x == 0) { st[0] = 0u; st[1] = 0u; st[2] = 0u; st[3] = 0u; }
    __syncthreads();
    if (HI - LO > 1) (void)xcd_barrier_post((unsigned*)(PK.ws + WS_CTL) + PK.ph_lo * XCD_BAR_WORDS, st);
#define IN(k) (LO <= (k) && (k) < HI)
#define PHASE(k) if (IN(k))
#define SEAM(k) do { if (IN(k) && IN((k) + 1)) { XcdBarrier b_; b_.bar = (unsigned*)(PK.ws + WS_CTL) + PK.ph_lo * XCD_BAR_WORDS; b_.x = xb_xcc_id(); b_.st = (volatile LAS unsigned*)(lds + MISC_OFF); xcd_barrier(b_); } } while (0)
    PHASE(0) {
        adaln_phase(P, lds);
        xpose_phase(P, lds);
        const float* ck = P.in[6]; bf16_t* KIS = (bf16_t*)(P.ws + WS_KIS);
        for (int t = blockIdx.x * NTHREADS + threadIdx.x; t < NB * PAST * 8; t += gridDim.x * NTHREADS) {
            const int b = t >> 13, rem = t & 8191;
            const f32x4 a = *(const f32x4*)(ck + (size_t)t * 8), c = *(const f32x4*)(ck + (size_t)t * 8 + 4);
            u32x4 o; o.x = cvt_pk_bf16(a[0], a[1]); o.y = cvt_pk_bf16(a[2], a[3]); o.z = cvt_pk_bf16(c[0], c[1]); o.w = cvt_pk_bf16(c[2], c[3]);
            *(u32x4*)(KIS + (size_t)b * LS * 64 + (size_t)rem * 8) = o;
        }
    }
    SEAM(0);
    PHASE(1) normmod_phase<0>(P);
    SEAM(1);
    PHASE(2) {
        pg8::Gemm g{(const bf16_t*)(P.ws + WS_H), (const bf16_t*)(P.ws + WS_WIN), MT, NPAD, DM}; pg8::StaticOrder S; S.init(MT, NPAD, (int)gridDim.x, (int)blockIdx.x);
        pg8::EpiIn E{P.out, P.ws};
        pg8::gemm_phase<pg8::EpiIn, pg8::StaticOrder>(lds, g, S, E, nullptr);
    }
    SEAM(2);
    PHASE(3) d1_phase(P, lds);
    SEAM(3);
    PHASE(4) d2_phase(P, lds);
    SEAM(4);
    PHASE(5) indexer_phase(P, lds);
    SEAM(5);
    PHASE(6) attn_phase(P, lds);
    SEAM(6);
    PHASE(7) merge_phase(P);
    SEAM(7);
    PHASE(8) {
        pg8::Gemm g{(const bf16_t*)(P.ws + WS_H), (const bf16_t*)(P.ws + WS_WOUT), MT, DM, DM}; pg8::StaticOrder S; S.init(MT, DM, (int)gridDim.x, (int)blockIdx.x);
        pg8::EpiRes<0> E{P.in[0], P.in[1], P.out, (const float*)(P.ws + WS_MOD)};
        pg8::gemm_phase<pg8::EpiRes<0>, pg8::StaticOrder>(lds, g, S, E, nullptr);
    }
    SEAM(8);
    PHASE(9) normmod_phase<1>(P);
    SEAM(9);
    PHASE(10) {
        pg8::Gemm g{(const bf16_t*)(P.ws + WS_H), (const bf16_t*)(P.ws + WS_WGU), MT, 2 * DFF, DM}; pg8::StaticOrder S; S.init(MT, 2 * DFF, (int)gridDim.x, (int)blockIdx.x);
        pg8::EpiGU E{P.out, P.ws};
        pg8::gemm_phase<pg8::EpiGU, pg8::StaticOrder>(lds, g, S, E, nullptr);
    }
    SEAM(10);
    PHASE(11) act_phase(P);
    SEAM(11);
    PHASE(12) {
        pg8::Gemm g{(const bf16_t*)(P.ws + WS_UP), (const bf16_t*)(P.ws + WS_WDN), MT, DM, DFF}; pg8::StaticOrder S; S.init(MT, DM, (int)gridDim.x, (int)blockIdx.x);
        pg8::EpiRes<1> E{P.in[0], P.in[1], P.out, (const float*)(P.ws + WS_MOD)};
        pg8::gemm_phase<pg8::EpiRes<1>, pg8::StaticOrder>(lds, g, S, E, nullptr);
    }
    SEAM(12);
    PHASE(13) finalnorm_phase(P);
#undef IN
#undef SEAM
}

extern "C" void kernel_launch(void* const* d_in, const int* in_sizes, int n_in, void* d_out, int out_size, void* d_ws, size_t ws_size, hipStream_t stream) {
    static int grid = 0;
    if (grid == 0) {
        if (n_in != 27 || out_size != (int)O_END || ws_size < WS_END) { fprintf(stderr, "kernel_launch: unexpected shapes (n_in %d, out %d, ws %zu, need %zu)\n", n_in, out_size, ws_size, (size_t)WS_END); grid = -1; return; }
        int dev = 0, cus = 0, per_cu = 0;
        if (hipGetDevice(&dev) != hipSuccess || hipDeviceGetAttribute(&cus, hipDeviceAttributeMultiprocessorCount, dev) != hipSuccess) { grid = -1; return; }
        hipError_t e = hipSuccess;
#define SETLDS(LO_, HI_) do { if (e == hipSuccess) e = hipFuncSetAttribute((const void*)(hybrid_fwd<LO_, HI_>), hipFuncAttributeMaxDynamicSharedMemorySize, LDS_BYTES); } while (0)
#if MK_MODE == 0
        SETLDS(0, 1); SETLDS(1, 2); SETLDS(2, 3); SETLDS(3, 4); SETLDS(4, 5); SETLDS(5, 6); SETLDS(6, 7); SETLDS(7, 8); SETLDS(8, 9); SETLDS(9, 10); SETLDS(10, 11); SETLDS(11, 12); SETLDS(12, 13); SETLDS(13, 14);
        const void* kq = (const void*)(hybrid_fwd<2, 3>);
#elif MK_MODE == 1
        SETLDS(0, 1); SETLDS(1, 14);
        const void* kq = (const void*)(hybrid_fwd<1, 14>);
#else
        SETLDS(0, 14);
        const void* kq = (const void*)(hybrid_fwd<0, 14>);
#endif
        if (e != hipSuccess) { fprintf(stderr, "kernel_launch: hipFuncSetAttribute failed\n"); grid = -1; return; }
        if (hipOccupancyMaxActiveBlocksPerMultiprocessor(&per_cu, kq, NTHREADS, LDS_BYTES) != hipSuccess || per_cu < 1) { fprintf(stderr, "kernel_launch: occupancy query says %d\n", per_cu); (void)hipGetLastError(); per_cu = 1; }
        grid = cus;
    }
    if (grid < 0) return;
    (void)hipMemsetAsync((char*)d_ws + WS_CTL, 0, 65536, stream);
    Params p{};
    for (int i = 0; i < 27; ++i) p.in[i] = (const float*)d_in[i];
    p.out = (float*)d_out; p.ws = (unsigned char*)d_ws;
#define LAUNCH(LO_, HI_, region) do { p.ph_lo = (region); p.ph_hi = 0; hipLaunchKernelGGL((hybrid_fwd<LO_, HI_>), dim3(grid), dim3(NTHREADS), LDS_BYTES, stream, p); } while (0)
#if MK_MODE == 0
    LAUNCH(0, 1, 0); LAUNCH(1, 2, 0); LAUNCH(2, 3, 0); LAUNCH(3, 4, 0); LAUNCH(4, 5, 0); LAUNCH(5, 6, 0); LAUNCH(6, 7, 0);
    LAUNCH(7, 8, 0); LAUNCH(8, 9, 0); LAUNCH(9, 10, 0); LAUNCH(10, 11, 0); LAUNCH(11, 12, 0); LAUNCH(12, 13, 0); LAUNCH(13, 14, 0);
#elif MK_MODE == 1
    LAUNCH(0, 1, 0); LAUNCH(1, 14, 1);
#else
    LAUNCH(0, 14, 0);
#endif
    const hipError_t le = hipPeekAtLastError();
    if (le != hipSuccess) fprintf(stderr, "kernel_launch: launch failed: %s\n", hipGetErrorName(le));
}
```

```cpp
#include <hip/hip_runtime.h>
#include <stdint.h>
#include <cstdio>

#define LAS __attribute__((address_space(3)))
typedef unsigned short bf16_t;
typedef short bf16x8 __attribute__((ext_vector_type(8)));
typedef short s16x4 __attribute__((ext_vector_type(4)));
typedef float f32x4 __attribute__((ext_vector_type(4)));
typedef float f32x2 __attribute__((ext_vector_type(2)));
typedef float f32x16 __attribute__((ext_vector_type(16)));
typedef unsigned u32x4 __attribute__((ext_vector_type(4)));
typedef unsigned u32x2 __attribute__((ext_vector_type(2)));

constexpr int DM = 2048, SEQ = 16384, NB = 32, TS = 64, PAST = 1024, LS = PAST + TS;
constexpr int MT = SEQ + NB * TS;
constexpr int NSEQ = 1 + NB;
constexpr int DFF = 5632, CONVB = 6144, DIN = 19568;
constexpr int NPAD = 19712;
constexpr int NUNIT = 288 * 16;
constexpr int UB_W = 0, UB_QG = 16896, UB_A = 33792, UB_KD = 42496, UB_U = 59904, UNITB = 76288, RW = 264, RA = 136;
constexpr size_t O_YP = 0, O_YS = 33554432, O_KP = 37748736, O_VP = 71303168, O_KIP = 104857600, O_CBP = 105906176, O_DP = 105924608, O_FP = 106186752,
                 O_KS = 106198016, O_VS = 110392320, O_KIS = 114586624, O_CBS = 114717696, O_DS = 115307520, O_FS = 123696128, O_END = 124056576;
constexpr size_t WS_CTL = 0, WS_MOD = 65536, WS_WI = WS_MOD + 1622016, WS_AB = WS_WI + 1179648, WS_BB = WS_AB + 1179648, WS_GL = WS_BB + 1179648,
                 WS_KIP = WS_GL + 18432, WS_KIS = WS_KIP + 2097152, WS_MASKP = WS_KIS + 4456448, WS_MASKS = WS_MASKP + 33554432, WS_WOUT = WS_MASKS + 294912,
                 WS_WGU = WS_WOUT + 8388608, WS_WDN = WS_WGU + 46137344, WS_WIN = WS_WDN + 23068672, WS_H = WS_WIN + 80740352, WS_Q = WS_H + 75497472,
                 WS_KP = WS_Q + 75497472, WS_VP = WS_KP + 67108864, WS_QI = WS_VP + 67108864, WS_QKVB = WS_QI + 37748736, WS_Z = WS_QKVB + 226492416,
                 WS_GA = WS_Z + 75497472, WS_GB = WS_GA + 75497472, WS_R2 = WS_GB + 75497472, WS_END = WS_R2 + 44323328;
constexpr size_t WS_PART = WS_Z;
constexpr size_t WS_SIDEG = WS_GA, WS_SIDEU = WS_GA + (size_t)288 * 4 * 5632 * 4;
constexpr size_t WS_OB = WS_QKVB;
constexpr size_t WS_GP = WS_Q, WS_UP = WS_Q + 207618048;
constexpr int R0_UNITS = 1979, R1_UNITS = 2048;
static_assert(WS_UP + 207618048 <= WS_Z, "ffn buffers overlap");
static_assert(WS_END <= 1073741824ull, "workspace budget");

constexpr int NTHREADS = 512;
constexpr int LDS_BYTES = 155648;
constexpr int MISC_OFF = 155648 - 256;

struct Params { const float* in[27]; float* out; unsigned char* ws; int ph_lo, ph_hi; };

typedef __bf16 bf16x2_n __attribute__((ext_vector_type(2)));
__device__ __forceinline__ unsigned cvt_pk_bf16(float lo, float hi) { const f32x2 f = {lo, hi}; const bf16x2_n v = __builtin_convertvector(f, bf16x2_n); return __builtin_bit_cast(unsigned, v); }
__device__ __forceinline__ bf16_t f2bf(float f) { return (bf16_t)(cvt_pk_bf16(f, 0.f) & 0xffffu); }
__device__ __forceinline__ float bf2f(bf16_t b) { return __uint_as_float(((unsigned)b) << 16); }
__device__ __forceinline__ float bflo(unsigned w) { return __uint_as_float(w << 16); }
__device__ __forceinline__ float bfhi(unsigned w) { return __uint_as_float(w & 0xffff0000u); }
__device__ __forceinline__ float wave_sum(float v) { v += __shfl_xor(v, 32); v += __shfl_xor(v, 16); v += __shfl_xor(v, 8); v += __shfl_xor(v, 4); v += __shfl_xor(v, 2); v += __shfl_xor(v, 1); return v; }
__device__ __forceinline__ float sigmoidf_(float x) { return __builtin_amdgcn_rcpf(1.0f + __expf(-x)); }
__device__ __forceinline__ float siluf_(float x) { return x * __builtin_amdgcn_rcpf(1.0f + __expf(-x)); }
__device__ __forceinline__ int seq_of_row(int m) { return m < SEQ ? 0 : 1 + ((m - SEQ) >> 6); }
__device__ __forceinline__ int crow(int r, int hi) { return (r & 3) + 8 * (r >> 2) + 4 * hi; }
__device__ __forceinline__ unsigned char* unit_ptr(const Params& P, int u) {
    if (u < R0_UNITS) return (unsigned char*)P.out + (size_t)u * UNITB;
    if (u < R0_UNITS + R1_UNITS) return P.ws + WS_WIN + (size_t)(u - R0_UNITS) * UNITB;
    return P.ws + WS_R2 + (size_t)(u - R0_UNITS - R1_UNITS) * UNITB;
}
#define XB_TMO      128
#define XB_XCNT(j)  (256  + 64 * (j))
#define XB_XSUB(j)  (1280 + 64 * (j))
#define XB_XGEN(j)  (2304 + 64 * (j))
#define XB_TOP      3328
#define XB_TOPGEN   3392
#define XCD_BAR_WORDS 3456
#define XB_SPIN_CAP (1u << 18)
#define LAS __attribute__((address_space(3)))

__device__ __forceinline__ unsigned xb_ld(unsigned* p)              { return __hip_atomic_load(p, __ATOMIC_RELAXED, __HIP_MEMORY_SCOPE_AGENT); }
__device__ __forceinline__ unsigned xb_add(unsigned* p, unsigned v) { return __hip_atomic_fetch_add(p, v, __ATOMIC_RELAXED, __HIP_MEMORY_SCOPE_AGENT); }
__device__ __forceinline__ unsigned xb_xcc_id() { return (unsigned)__builtin_amdgcn_s_getreg((3 << 11) | 20) & 0xFu; }
#define XB_SPIN(cond, bar) do { unsigned _sp = 0; while (cond) { __builtin_amdgcn_s_sleep(1); \
    if ((++_sp & 255u) == 0u) { if (xb_ld(&(bar)[XB_TMO])) break; if (_sp > XB_SPIN_CAP) { atomicAdd(&(bar)[XB_TMO], 1u); break; } } } } while (0)

struct XcdBarrier {
    unsigned* bar; unsigned x;
    volatile LAS unsigned* st;
};

__device__ __forceinline__ XcdBarrier xcd_barrier_post(unsigned* bar, volatile LAS unsigned* st) {
    XcdBarrier b; b.bar = bar; b.x = xb_xcc_id(); b.st = st;
    if (threadIdx.x == 0) (void)xb_add(&bar[XB_XCNT(b.x)], 1u);
    return b;
}
__device__ __forceinline__ void xcd_barrier_complete(unsigned* bar, unsigned x, unsigned& nloc, unsigned& nx) {
    const unsigned G = gridDim.x * gridDim.y * gridDim.z;
    unsigned sum, cnt, mine, sp = 0u;
    for (;;) {
        sum = 0u; cnt = 0u; mine = 0u;
#pragma unroll
        for (unsigned j = 0; j < 16; ++j) { const unsigned c = xb_ld(&bar[XB_XCNT(j)]); sum += c; cnt += (c > 0u) ? 1u : 0u; mine = (j == x) ? c : mine; }
        if (sum == G) break;
        __builtin_amdgcn_s_sleep(1);
        if ((++sp & 255u) == 0u) { if (xb_ld(&bar[XB_TMO])) break; if (sp > XB_SPIN_CAP) { atomicAdd(&bar[XB_TMO], 1u); break; } }
    }
    nloc = mine > 0u ? mine : 1u; nx = cnt > 0u ? cnt : 1u;
}

__device__ __forceinline__ void xcd_barrier(const XcdBarrier& b) {
    asm volatile("s_waitcnt vmcnt(0)" ::: "memory");
    __syncthreads();
    if (threadIdx.x == 0) {
        unsigned* bar = b.bar;
        __builtin_amdgcn_s_waitcnt(0);
        unsigned nloc = b.st[0], nx = b.st[1];
        if (nloc == 0u) { xcd_barrier_complete(bar, b.x, nloc, nx); b.st[0] = nloc; b.st[1] = nx; }
        const unsigned old = xb_add(&bar[XB_XSUB(b.x)], 1u);
        const unsigned gen = old / nloc;
        if (old + 1u == (gen + 1u) * nloc) {
            __builtin_amdgcn_fence(__ATOMIC_RELEASE, "agent");
            asm volatile("s_waitcnt vmcnt(0)" ::: "memory");
            const unsigned og = xb_add(&bar[XB_TOP], 1u);
            const unsigned tg = og / nx;
            if (og + 1u == (tg + 1u) * nx) xb_add(&bar[XB_TOPGEN], 1u);
            else XB_SPIN(xb_ld(&bar[XB_TOPGEN]) == tg, bar);
            __builtin_amdgcn_fence(__ATOMIC_ACQUIRE, "agent");
            xb_add(&bar[XB_XGEN(b.x)], 1u);
            asm volatile("s_waitcnt vmcnt(0)" ::: "memory");
        } else {
            XB_SPIN(xb_ld(&bar[XB_XGEN(b.x)]) == gen, bar);
            __builtin_amdgcn_fence(__ATOMIC_ACQUIRE, "agent");
            asm volatile("s_waitcnt vmcnt(0)" ::: "memory");
        }
    }
    __syncthreads();
}
namespace pg8 {
#define PG8_LAS __attribute__((address_space(3)))
typedef unsigned short bf16_t;
typedef short bf16x8 __attribute__((ext_vector_type(8)));
typedef float f32x4 __attribute__((ext_vector_type(4)));
typedef unsigned u32x4 __attribute__((ext_vector_type(4)));
constexpr int BM = 256, BK = 64, HALF = 128, HTB = HALF * BK * 2  , STAGE_BYTES = 8 * HTB, NXCD = 8, WGM = 8;

__host__ __device__ __forceinline__ int lds_byte(int r, int c) { const int st = (r >> 4) * 2 + (c >> 5), rr = r & 15, cc = c & 31, ob = rr * 64 + cc * 2; return st * 1024 + (ob ^ (((ob >> 9) & 1) << 5)); }
__host__ __device__ __forceinline__ void stage_rc(int b, int& R, int& C) { const int st = b / 1024, sb = b % 1024, swz = sb ^ (((sb >> 9) & 1) << 5); R = (st >> 1) * 16 + swz / 64; C = (st & 1) * 32 + (swz % 64) / 2; }
__host__ __device__ __forceinline__ int perm32(int rho) { const int n = rho >> 4, i = rho & 15; return 8 * (i >> 2) + 4 * n + (i & 3); }

struct Unit { int pm, pn, ks; };
struct Gemm { const bf16_t* A; const bf16_t* Bt; int M, N, K; };

struct StaticOrder {
    int nM, nN, nwg, G, c;
    __host__ __device__ void init(int M, int N, int G_, int c_) { nM = M / BM; nN = N / BM; nwg = nM * nN; G = G_; c = c_; }
    __host__ __device__ bool next(int i, Unit& u) const {
        const long L = (long)i * G + c; if (L >= nwg) return false;
        int wgid = (int)L; { const int q = nwg / NXCD, r = nwg % NXCD, xcd = wgid % NXCD, off = wgid / NXCD; wgid = (xcd < r ? xcd * (q + 1) : r * (q + 1) + (xcd - r) * q) + off; }
        const int nig = WGM * nN, gid = wgid / nig, fm = gid * WGM, gsz = (nM - fm) < WGM ? (nM - fm) : WGM;
        u.pm = fm + ((wgid % nig) % gsz); u.pn = (wgid % nig) / gsz; u.ks = 0; return true;
    }
    __device__ __forceinline__ void a_ready(const Unit&) const {}
    __device__ __forceinline__ void done(const Unit&) const {}
};
struct SplitOrder : StaticOrder {
    __host__ __device__ bool next(int i, Unit& u) const {
        if (!(G == 256 && nM == 72 && nN == 8)) return StaticOrder::next(i, u);
        const int x = c & 7, j = c >> 3;
        if (i < 2) { const int off = j + 32 * i; u.pm = 8 * x + (off & 7); u.pn = off >> 3; u.ks = 0; return true; }
        if (i == 2) { u.pm = 64 + (j & 7); u.pn = x; u.ks = 1 + (j >> 3); return true; }
        return false;
    }
};
struct CountedOrder : StaticOrder {
    const unsigned* ready; unsigned need; unsigned* tmo;
    __device__ __forceinline__ void a_ready(const Unit& u) const {
        if (threadIdx.x < 64) {
            const unsigned long long t0 = __builtin_amdgcn_s_memrealtime(); unsigned polls = 0;
            while ((unsigned)__builtin_amdgcn_readfirstlane(__hip_atomic_load(ready + 64 * u.pm, __ATOMIC_RELAXED, __HIP_MEMORY_SCOPE_AGENT)) < need) {
                if ((++polls & 255u) == 0u && __builtin_amdgcn_readfirstlane(__hip_atomic_load(tmo, __ATOMIC_RELAXED, __HIP_MEMORY_SCOPE_AGENT)) != 0u) break;
                if (__builtin_amdgcn_s_memrealtime() - t0 > 2000000ull) {
                    if (threadIdx.x == 0) { unsigned expect = 0u; __hip_atomic_compare_exchange_strong(tmo + 1, &expect, 0x600u | (unsigned)(u.pm & 0xff), __ATOMIC_RELAXED, __ATOMIC_RELAXED, __HIP_MEMORY_SCOPE_AGENT); __hip_atomic_store(tmo, 1u, __ATOMIC_RELAXED, __HIP_MEMORY_SCOPE_AGENT); }
                    break; }
                __builtin_amdgcn_s_sleep(2); }
            __builtin_amdgcn_fence(__ATOMIC_ACQUIRE, "agent");
            asm volatile("s_waitcnt vmcnt(0)" ::: "memory");
        }
#if !defined(BROKEN_HOOK_NO_BARRIER)
        asm volatile("" ::: "memory"); __builtin_amdgcn_s_barrier(); asm volatile("" ::: "memory");
#endif
    }
};
__device__ __forceinline__ u32x4 pack8(const f32x4 a, const f32x4 b) { u32x4 w; w.x = cvt_pk_bf16(a[0], a[1]); w.y = cvt_pk_bf16(a[2], a[3]); w.z = cvt_pk_bf16(b[0], b[1]); w.w = cvt_pk_bf16(b[2], b[3]); return w; }

template <class T> __device__ __forceinline__ void gst(void* p, const T v) { *(__attribute__((address_space(1))) T*)p = v; }
template <class T> __device__ __forceinline__ T gld(const void* p) { return *(const __attribute__((address_space(1))) T*)p; }
struct EpiIn {
    static constexpr bool PERM = true, AFTER_DRAIN = false;
    float* out; unsigned char* ws;
    template <int SEG> __device__ __forceinline__ void seg(const f32x4 (&acc)[2][2][4][2], const Unit& u, int wr, int wc, int fr, int fq, float* outp, unsigned char* wsp) const {
        const int pn = u.pn;
#pragma unroll
        for (int ai = 0; ai < 2; ++ai)
#pragma unroll
            for (int m = 0; m < 4; ++m) {
                const int r = u.pm * BM + ai * HALF + wr * 64 + m * 16 + fr;
                const bool isP = r < SEQ; const int rs = r - SEQ;
#pragma unroll
                for (int bj = 0; bj < 2; ++bj) {
                    const int cb = bj * HALF + wc * 32 + 8 * fq;
                    f32x4 v0 = acc[ai][bj][m][0], v1 = acc[ai][bj][m][1];
                    if (SEG == 0) {
                        gst<u32x4>(((bf16_t*)(wsp + WS_Q) + (size_t)r * DM + pn * 256 + cb), pack8(v0, v1));
                    } else if (SEG == 1) {
                        const bool isK = pn < 16; const int col = (pn - (isK ? 8 : 16)) * 256 + cb;
                        float* dst = outp + (isP ? (isK ? O_KP : O_VP) + (size_t)r * DM : (isK ? O_KS : O_VS) + (size_t)rs * DM) + col;
                        gst<f32x4>(dst, v0); gst<f32x4>((dst + 4), v1);
                        if (isP) gst<u32x4>(((bf16_t*)(wsp + (isK ? WS_KP : WS_VP)) + (size_t)r * DM + col), pack8(v0, v1));
                    } else if (SEG == 2) {
                        gst<u32x4>(((bf16_t*)(wsp + WS_QI) + (size_t)r * 1024 + (pn - 24) * 256 + cb), pack8(v0, v1));
                    } else if (SEG == 3) {
                        const int col = (pn - 28) * 256 + cb;
                        gst<u32x4>(((bf16_t*)(wsp + WS_QKVB) + (size_t)r * CONVB + col), pack8(v0, v1));
                        const int t = isP ? r - (SEQ - 64) : (rs & 63);
                        if (t >= 61 && t < 64) {
                            float* dst = outp + (isP ? O_CBP : O_CBS + (size_t)(rs >> 6) * 3 * CONVB) + (size_t)(t - 61) * CONVB + col;
                            gst<f32x4>(dst, v0); gst<f32x4>((dst + 4), v1);
                        }
                    } else if (SEG == 4) {
                        const int sg = (pn - 52) >> 3; const int col = ((pn - 52) & 7) * 256 + cb;
#pragma unroll
                        for (int j = 0; j < 4; ++j) {
                            if (sg == 0) { v0[j] = siluf_(v0[j]); v1[j] = siluf_(v1[j]); } else { v0[j] = sigmoidf_(v0[j]); v1[j] = sigmoidf_(v1[j]); }
                        }
                        gst<u32x4>(((bf16_t*)(wsp + (sg == 0 ? WS_Z : (sg == 1 ? WS_GA : WS_GB))) + (size_t)r * DM + col), pack8(v0, v1));
                    } else {
                        if (cb < 64) {
                            float* dst = outp + (isP ? O_KIP + (size_t)r * 64 : O_KIS + (size_t)rs * 64) + cb;
                            gst<f32x4>(dst, v0); gst<f32x4>((dst + 4), v1);
                            bf16_t* kb = isP ? (bf16_t*)(wsp + WS_KIP) + (size_t)r * 64 : (bf16_t*)(wsp + WS_KIS) + ((size_t)(rs >> 6) * LS + PAST + (rs & 63)) * 64;
                            gst<u32x4>((kb + cb), pack8(v0, v1));
                        } else if (cb < 112) {
                            const int which = cb < 80 ? 0 : (cb < 96 ? 1 : 2); const int c16 = cb - (which == 0 ? 64 : (which == 1 ? 80 : 96));
                            float* dst = (float*)(wsp + (which == 0 ? WS_WI : (which == 1 ? WS_AB : WS_BB))) + (size_t)r * 16 + c16;
                            const float sc = which == 0 ? 0.03125f : 1.0f;
                            gst<f32x4>(dst, v0 * sc); gst<f32x4>((dst + 4), v1 * sc);
                        }
                    }
                }
            }
    }
    __device__ __forceinline__ void operator()(const f32x4 (&acc)[2][2][4][2], const Unit& u, int wr, int wc, int fr, int fq) const {
        float* outp = out; unsigned char* wsp = ws;
        asm volatile("" : "+s"(outp), "+s"(wsp));
        const int pn = u.pn;
        if (pn < 8) seg<0>(acc, u, wr, wc, fr, fq, outp, wsp);
        else if (pn < 24) seg<1>(acc, u, wr, wc, fr, fq, outp, wsp);
        else if (pn < 28) seg<2>(acc, u, wr, wc, fr, fq, outp, wsp);
        else if (pn < 52) seg<3>(acc, u, wr, wc, fr, fq, outp, wsp);
        else if (pn < 76) seg<4>(acc, u, wr, wc, fr, fq, outp, wsp);
        else seg<5>(acc, u, wr, wc, fr, fq, outp, wsp);
    }
};

template <int WHICH> struct EpiRes {
    static constexpr bool PERM = false, AFTER_DRAIN = false;
    const float* xp; const float* xs; float* Y; const float* mod;
    __device__ __forceinline__ void operator()(const f32x4 (&acc)[2][2][4][2], const Unit& u, int wr, int wc, int fr, int fq) const {
        if (u.ks) {
            float* pp = (float*)((unsigned char*)const_cast<float*>(mod) + (WS_PART - WS_MOD)) + (size_t)(u.ks - 1) * ((size_t)(MT - SEQ) * DM);
#pragma unroll
            for (int ai = 0; ai < 2; ++ai)
#pragma unroll
                for (int m = 0; m < 4; ++m) {
                    float* dst = pp + (size_t)(u.pm * BM + ai * HALF + wr * 64 + m * 16 + fr - SEQ) * DM;
#pragma unroll
                    for (int bj = 0; bj < 2; ++bj)
#pragma unroll
                        for (int n = 0; n < 2; ++n) gst<f32x4>((dst + u.pn * BM + bj * HALF + wc * 32 + n * 16 + 4 * fq), acc[ai][bj][m][n]);
                }
            return;
        }
#pragma unroll
        for (int ai = 0; ai < 2; ++ai)
#pragma unroll
            for (int m = 0; m < 4; ++m) {
                const int r = u.pm * BM + ai * HALF + wr * 64 + m * 16 + fr;
                const int s = seq_of_row(r);
                const float* gate = mod + (size_t)s * 12288 + (WHICH == 0 ? 4096 : 10240);
                const float* base = WHICH == 0 ? (r < SEQ ? xp + (size_t)r * DM : xs + (size_t)(r - SEQ) * DM) : Y + (size_t)r * DM;
                float* dst = Y + (size_t)r * DM;
#pragma unroll
                for (int bj = 0; bj < 2; ++bj)
#pragma unroll
                    for (int n = 0; n < 2; ++n) {
                        const int c = u.pn * BM + bj * HALF + wc * 32 + n * 16 + 4 * fq;
                        const f32x4 g = gld<f32x4>((gate + c)), b = gld<f32x4>((base + c));
                        gst<f32x4>((dst + c), b + g * acc[ai][bj][m][n]);
                    }
            }
    }
};

template <int CTRL> __device__ __forceinline__ float dpp_f(float old, float src) { return __int_as_float(__builtin_amdgcn_update_dpp(__float_as_int(old), __float_as_int(src), CTRL, 0xf, 0xf, false)); }
struct EpiGU {
    static constexpr bool PERM = true, AFTER_DRAIN = false;
    float* out; unsigned char* ws; const float* cw; const float* cb; const float* st;
    __device__ __forceinline__ void operator()(const f32x4 (&acc)[2][2][4][2], const Unit& u, int wr, int wc, int fr, int fq) const {
        float* out = this->out; unsigned char* ws = this->ws; const float* cw = this->cw; const float* cb = this->cb; const float* st = this->st;
        asm volatile("" : "+s"(out), "+s"(ws), "+s"(cw), "+s"(cb), "+s"(st));
        int fr_ = fr; asm volatile("" : "+v"(fr_));
#pragma unroll
        for (int ai = 0; ai < 2; ++ai) {
            const int R0 = u.pm * BM + ai * HALF + wr * 64; const bool isP = R0 < SEQ;
            unsigned pk0[4][2];
#pragma unroll
            for (int hc = 0; hc < 2; ++hc) {
                const int f = u.pn * 128 + wc * 32 + 8 * fq + 4 * hc;
                const f32x4 w0 = gld<f32x4>((cw + f)), w1 = gld<f32x4>((cw + DFF + f)), w2 = gld<f32x4>((cw + 2 * DFF + f)), bb = gld<f32x4>((cb + f));
                f32x4 cprev = {0.f, 0.f, 0.f, 0.f};
                if (!isP) { const float* sp = st + (size_t)((R0 - SEQ) >> 6) * 2 * DFF + f; const f32x4 s0 = gld<f32x4>(sp), s1 = gld<f32x4>((sp + DFF)); cprev = fr_ == 14 ? s0 : s1; }
#pragma unroll
                for (int m = 0; m < 4; ++m) {
                    const f32x4 g = acc[ai][0][m][hc], up = acc[ai][1][m][hc]; const f32x4 gp = m == 0 ? cprev : acc[ai][0][m - 1][hc];
                    const int r = R0 + m * 16 + fr_;
                    f32x4 y;
#pragma unroll
                    for (int q = 0; q < 4; ++q) {
                        const float p1 = dpp_f<0x111>(dpp_f<0x10F>(0.f, gp[q]), g[q]);
                        const float p2 = dpp_f<0x112>(dpp_f<0x10E>(0.f, gp[q]), g[q]);
                        const float a = fmaf(w0[q], p2, fmaf(w1[q], p1, fmaf(w2[q], g[q], bb[q])));
                        y[q] = siluf_(a) * up[q];
                    }
                    const unsigned y01 = cvt_pk_bf16(y[0], y[1]), y23 = cvt_pk_bf16(y[2], y[3]);
                    if (hc == 0) { pk0[m][0] = y01; pk0[m][1] = y23; }
                    else { u32x4 o; o.x = pk0[m][0]; o.y = pk0[m][1]; o.z = y01; o.w = y23; gst<u32x4>(((bf16_t*)(ws + WS_UP) + (size_t)r * DFF + f - 4), o); }
                    if (m == 0 || m == 3) {
                        const int t = m * 16 + fr_;
                        if (isP && (t < 2 || t >= 62)) {
                            gst<f32x4>(((float*)(ws + WS_SIDEG) + ((size_t)(r >> 6) * 4 + ((t + 2) & 3)) * DFF + f), g);
                            if (t < 2) gst<f32x4>(((float*)(ws + WS_SIDEU) + ((size_t)(r >> 6) * 2 + t) * DFF + f), up);
                        }
                        if (m == 3 && t >= 62 && (!isP || R0 == SEQ - 64))
                            gst<f32x4>((out + (isP ? O_FP : O_FS + (size_t)((R0 - SEQ) >> 6) * 2 * DFF) + (size_t)(t - 62) * DFF + f), g);
                    }
                }
            }
        }
    }
};

template <class Epi, class Sched, bool STAMP = false>
__device__ __forceinline__ void gemm_phase(PG8_LAS unsigned char* lds, const Gemm g, const Sched& S, const Epi& E, unsigned long long* stamps) {
    int tid_ = threadIdx.x; asm volatile("" : "+v"(tid_));
    const int tid = tid_, wid = __builtin_amdgcn_readfirstlane(tid >> 6), lane = tid & 63, wr = wid >> 2, wc = wid & 3, fr = lane & 15, fq = lane >> 4;
    const int K = g.K, nt = K / BK;
    int ts_lo = 0, ts_hi = 0, nts = 0; const unsigned long long rt_entry = STAMP ? (unsigned long long)wall_clock64() : 0ull;
#define PG8_STAMP() do { if (STAMP && wid == 0 && nts < 64) { const unsigned long long _c = (unsigned long long)clock64(); \
        ts_lo = (lane == nts) ? (int)(unsigned)_c : ts_lo; ts_hi = (lane == nts) ? (int)(unsigned)(_c >> 32) : ts_hi; ++nts; } } while (0)
    PG8_STAMP();
    unsigned voffA[2], voffB[2];
#pragma unroll
    for (int i = 0; i < 2; ++i) { int R, C; stage_rc(tid * 16 + i * 8192, R, C); const int Rb = Epi::PERM ? ((R & ~31) + perm32(R & 31)) : R;
        voffA[i] = (unsigned)(R * K + C) * 2u; voffB[i] = (unsigned)(Rb * K + C) * 2u; }
    const size_t kstep = (size_t)(BK * 2);
    const size_t hstep = (size_t)HALF * K * 2;
    const size_t tstep = 2 * hstep;
    auto koff = [&](const Unit& u) -> size_t { return u.ks ? (size_t)((u.ks - 1) * (nt >> 2)) * kstep : (size_t)0; };
    const unsigned ldsw = (unsigned)wid * 1024u;
    const int aoff = lds_byte(wr * 64 + fr, fq * 8), boff = lds_byte(wc * 32 + fr, fq * 8);
#define PG8_SA(b, h) (((b) * 2 + (h)) * HTB)
#define PG8_SB(b, h) ((4 + (b) * 2 + (h)) * HTB)
#define PG8_STAGE(bufoff, gbase, voff) do { _Pragma("unroll") for (int _i = 0; _i < 2; ++_i) \
        __builtin_amdgcn_global_load_lds((const unsigned*)((const char*)(gbase) + (voff)[_i]), (PG8_LAS unsigned*)(lds + (bufoff) + ldsw + _i * 8192), 16, 0, 0); } while (0)
#define PG8_LDA(dst, b, h) do { _Pragma("unroll") for (int m = 0; m < 4; ++m) _Pragma("unroll") for (int k = 0; k < 2; ++k) dst[m][k] = *(const PG8_LAS bf16x8*)(lds + PG8_SA(b, h) + aoff + m * 2048 + k * 1024); } while (0)
#define PG8_LDB(dst, b, h) do { _Pragma("unroll") for (int n = 0; n < 2; ++n) _Pragma("unroll") for (int k = 0; k < 2; ++k) dst[n][k] = *(const PG8_LAS bf16x8*)(lds + PG8_SB(b, h) + boff + n * 2048 + k * 1024); } while (0)
#define PG8_MMA(ai, bj, At, Bt) do { __builtin_amdgcn_s_setprio(1); _Pragma("unroll") for (int m = 0; m < 4; ++m) _Pragma("unroll") for (int n = 0; n < 2; ++n) _Pragma("unroll") for (int k = 0; k < 2; ++k) \
        acc[ai][bj][m][n] = __builtin_amdgcn_mfma_f32_16x16x32_bf16(Bt[n][k], At[m][k], acc[ai][bj][m][n], 0, 0, 0); __builtin_amdgcn_s_setprio(0); } while (0)
#define PG8_WAIT_V(n) asm volatile("s_waitcnt vmcnt(" #n ")" ::: "memory")
#define PG8_WAIT_L(n) asm volatile("s_waitcnt lgkmcnt(" #n ")" ::: "memory")
#define PG8_BAR __builtin_amdgcn_s_barrier()
#define PG8_SCHED __builtin_amdgcn_sched_barrier(0)
    Unit cur, nxt; int ui = 0;
    if (!S.next(0, cur)) return;
    f32x4 acc[2][2][4][2];
#pragma unroll
    for (int a = 0; a < 2; ++a)
#pragma unroll
        for (int b = 0; b < 2; ++b)
#pragma unroll
            for (int m = 0; m < 4; ++m)
#pragma unroll
                for (int n = 0; n < 2; ++n) acc[a][b][m][n] = (f32x4){0.f, 0.f, 0.f, 0.f};
    bf16x8 At[4][2], B0[2][2], B1[2][2];
    const char* cA = (const char*)g.A + (size_t)cur.pm * tstep + koff(cur); const char* cB = (const char*)g.Bt + (size_t)cur.pn * tstep + koff(cur);
    S.a_ready(cur);
    PG8_STAGE(PG8_SB(0, 0), cB, voffB); PG8_STAGE(PG8_SA(0, 0), cA, voffA); PG8_STAGE(PG8_SB(0, 1), cB + hstep, voffB); PG8_STAGE(PG8_SA(0, 1), cA + hstep, voffA);
    if (wr == 1) PG8_BAR;
    PG8_WAIT_V(4); PG8_BAR;
    PG8_STAGE(PG8_SB(1, 0), cB + kstep, voffB); PG8_STAGE(PG8_SA(1, 0), cA + kstep, voffA); PG8_STAGE(PG8_SB(1, 1), cB + hstep + kstep, voffB);
    PG8_WAIT_V(6); PG8_BAR;
    PG8_STAMP();
    for (;;) {
        const bool has_next = S.next(ui + 1, nxt);
        const char* nA = has_next ? (const char*)g.A + (size_t)nxt.pm * tstep + koff(nxt) : cA; const char* nB = has_next ? (const char*)g.Bt + (size_t)nxt.pn * tstep + koff(nxt) : cB;
        const int unt = cur.ks ? (nt >> 2) : nt;
        for (int t = 0; t < unt; t += 2) {
            const bool last = (t == unt - 2);
            const char* a1 = cA + (size_t)(t + 1) * kstep;
            const char* a2 = last ? nA : cA + (size_t)(t + 2) * kstep; const char* b2 = last ? nB : cB + (size_t)(t + 2) * kstep;
            const char* a3 = a2 + kstep; const char* b3 = b2 + kstep;
            if (last && has_next) S.a_ready(nxt);
            PG8_LDB(B0, 0, 0); PG8_SCHED; PG8_LDA(At, 0, 0); PG8_STAGE(PG8_SA(1, 1), a1 + hstep, voffA);
            PG8_WAIT_L(8); PG8_BAR; PG8_WAIT_L(0); PG8_MMA(0, 0, At, B0); PG8_BAR; PG8_SCHED;
            PG8_LDB(B1, 0, 1); PG8_STAGE(PG8_SB(0, 0), b2, voffB);
            PG8_BAR; PG8_WAIT_L(0); PG8_MMA(0, 1, At, B1); PG8_BAR;
            PG8_LDA(At, 0, 1); PG8_STAGE(PG8_SA(0, 0), a2, voffA);
            PG8_BAR; PG8_WAIT_L(0); PG8_MMA(1, 0, At, B0); PG8_BAR; PG8_SCHED;
            PG8_STAGE(PG8_SB(0, 1), b2 + hstep, voffB);
            PG8_WAIT_V(6); PG8_BAR; PG8_MMA(1, 1, At, B1); PG8_BAR;
            PG8_LDB(B0, 1, 0); PG8_SCHED; PG8_LDA(At, 1, 0); PG8_STAGE(PG8_SA(0, 1), a2 + hstep, voffA);
            PG8_WAIT_L(8); PG8_BAR; PG8_WAIT_L(0); PG8_MMA(0, 0, At, B0); PG8_BAR; PG8_SCHED;
            PG8_LDB(B1, 1, 1); PG8_STAGE(PG8_SB(1, 0), b3, voffB);
            PG8_BAR; PG8_WAIT_L(0); PG8_MMA(0, 1, At, B1); PG8_BAR;
            PG8_LDA(At, 1, 1); PG8_STAGE(PG8_SA(1, 0), a3, voffA);
            PG8_BAR; PG8_WAIT_L(0); PG8_MMA(1, 0, At, B0); PG8_BAR; PG8_SCHED;
            PG8_STAGE(PG8_SB(1, 1), b3 + hstep, voffB);
            PG8_WAIT_V(6); PG8_BAR; PG8_MMA(1, 1, At, B1); PG8_BAR;
        }
        PG8_STAMP();
        if constexpr (!Epi::AFTER_DRAIN) { E(acc, cur, wr, wc, fr, fq); S.done(cur); }
        PG8_STAMP();
        if (!has_next) break;
#pragma unroll
        for (int a = 0; a < 2; ++a)
#pragma unroll
            for (int b = 0; b < 2; ++b)
#pragma unroll
                for (int m = 0; m < 4; ++m)
#pragma unroll
                    for (int n = 0; n < 2; ++n) acc[a][b][m][n] = (f32x4){0.f, 0.f, 0.f, 0.f};
        cur = nxt; cA = nA; cB = nB; ++ui;
    }
    PG8_WAIT_V(0);
    if (wr == 0) PG8_BAR;
    PG8_BAR;
    if constexpr (Epi::AFTER_DRAIN) { E.fused(acc, cur, wr, wc, fr, fq, lds, wid, lane); S.done(cur); }
    PG8_STAMP();
    if (STAMP && wid == 0) { stamps[lane] = lane < nts ? (((unsigned long long)(unsigned)ts_hi << 32) | (unsigned)ts_lo) : 0ull;
        if (lane == 62) stamps[62] = rt_entry; if (lane == 63) stamps[63] = (unsigned long long)wall_clock64(); }
#undef PG8_STAMP
#undef PG8_SA
#undef PG8_SB
#undef PG8_STAGE
#undef PG8_LDA
#undef PG8_LDB
#undef PG8_MMA
#undef PG8_WAIT_V
#undef PG8_WAIT_L
#undef PG8_BAR
#undef PG8_SCHED
}
}
__device__ __forceinline__ void adaln_phase(const Params& P, LAS unsigned char* lds) {
    int tid = threadIdx.x; asm volatile("" : "+v"(tid)); const int w = tid >> 6, lane = tid & 63;
    LAS float* sc = (LAS float*)lds;
    LAS float* red = (LAS float*)(lds + 33792);
    const float* cp = P.in[2]; const float* cs = P.in[3]; const float* wada = P.in[12]; const float* bada = P.in[13];
    float* mod = (float*)(P.ws + WS_MOD);
    for (int j = blockIdx.x; j < 192; j += gridDim.x) {
        float acc[NSEQ];
#pragma unroll
        for (int s = 0; s < NSEQ; ++s) acc[s] = 0.f;
        for (int kc = 0; kc < 8; ++kc) {
            const int k0 = kc * 256;
            __syncthreads();
            for (int idx = tid; idx < NSEQ * 256; idx += NTHREADS) {
                const int s = idx >> 8, kk = idx & 255;
                const float c = s == 0 ? cp[k0 + kk] : cs[(size_t)(s - 1) * DM + k0 + kk];
                sc[idx] = c / (1.0f + expf(-c));
            }
            __syncthreads();
            for (int kk = 0; kk < 32; kk += 4) {
                float wv[4];
#pragma unroll
                for (int q = 0; q < 4; ++q) wv[q] = wada[(size_t)(k0 + 32 * w + kk + q) * 12288 + 64 * j + lane];
#pragma unroll
                for (int s = 0; s < NSEQ; ++s) {
                    const f32x4 c4 = *(const LAS f32x4*)(sc + s * 256 + 32 * w + kk);
                    acc[s] = fmaf(c4[0], wv[0], acc[s]); acc[s] = fmaf(c4[1], wv[1], acc[s]); acc[s] = fmaf(c4[2], wv[2], acc[s]); acc[s] = fmaf(c4[3], wv[3], acc[s]);
                }
            }
        }
#pragma unroll
        for (int s = 0; s < NSEQ; ++s) red[(w * NSEQ + s) * 64 + lane] = acc[s];
        __syncthreads();
        for (int idx = tid; idx < NSEQ * 64; idx += NTHREADS) {
            const int s = idx >> 6, col = idx & 63; float v = bada[64 * j + col];
#pragma unroll
            for (int ww = 0; ww < 8; ++ww) v += red[(ww * NSEQ + s) * 64 + col];
            mod[(size_t)s * 12288 + 64 * j + col] = v;
        }
        __syncthreads();
    }
}

__device__ __forceinline__ int win_src_col(int n) {
    if (n < 7168) return n;
    if (n < 13312) return 7248 + (n - 7168);
    if (n < 19456) return 13424 + (n - 13312);
    const int q = n - 19456;
    if (q < 80) return 7168 + q;
    if (q < 112) return 13392 + (q - 80);
    return -1;
}
__device__ __forceinline__ void xpose_jobs(const Params& P, LAS unsigned char* lds, const int jlo, const int jhi, const int first, const int stride) {
    int tid = threadIdx.x; asm volatile("" : "+v"(tid)); const int tx = tid & 63, ty = tid >> 6, nl = tid >> 3, ks = tid & 7;
    LAS float* tile = (LAS float*)lds;
    constexpr int J0 = 77 * 32, J1 = J0 + 8 * 32, J2 = J1 + 44 * 32, J3 = J2 + 8 * 88;
    for (int j = jlo + first; j < jhi; j += stride) {
        const float* src0; const float* src1; int ld, K, nt, kt, which; bf16_t* dst;
        if (j < J0)      { nt = j >> 5; kt = j & 31; src0 = src1 = P.in[15]; ld = DIN; K = DM; dst = (bf16_t*)(P.ws + WS_WIN); which = 0; }
        else if (j < J1) { const int q = j - J0; nt = q >> 5; kt = q & 31; src0 = src1 = P.in[20]; ld = DM; K = DM; dst = (bf16_t*)(P.ws + WS_WOUT); which = 1; }
        else if (j < J2) { const int q = j - J1; nt = q >> 5; kt = q & 31; src0 = P.in[22]; src1 = P.in[25]; K = DM; ld = DFF; dst = (bf16_t*)(P.ws + WS_WGU); which = 2; }
        else             { const int q = j - J2; nt = q / 88; kt = q % 88; src0 = src1 = P.in[26]; ld = DM; K = DFF; dst = (bf16_t*)(P.ws + WS_WDN); which = 1; }
        const int k0 = kt * 64;
        float v[32];
#pragma unroll
        for (int c = 0; c < 4; ++c) {
            const int n = nt * 256 + c * 64 + tx;
            const int sc = which == 0 ? win_src_col(n) : (which == 2 ? nt * 128 + ((c & 1) * 64 + tx) : n);
            const float* sp = (which == 2 && c >= 2) ? src1 : src0;
#pragma unroll
            for (int i = 0; i < 8; ++i) v[c * 8 + i] = sc >= 0 ? sp[(size_t)(k0 + ty + 8 * i) * ld + sc] : 0.f;
        }
#pragma unroll
        for (int c = 0; c < 4; ++c)
#pragma unroll
            for (int i = 0; i < 8; ++i) tile[(ty + 8 * i) * 257 + c * 64 + tx] = v[c * 8 + i];
        __syncthreads();
#pragma unroll
        for (int c = 0; c < 4; ++c) {
            float o[8];
#pragma unroll
            for (int q = 0; q < 8; ++q) o[q] = tile[(ks * 8 + q) * 257 + c * 64 + nl];
            u32x4 wv; wv.x = cvt_pk_bf16(o[0], o[1]); wv.y = cvt_pk_bf16(o[2], o[3]); wv.z = cvt_pk_bf16(o[4], o[5]); wv.w = cvt_pk_bf16(o[6], o[7]);
            *(u32x4*)(dst + (size_t)(nt * 256 + c * 64 + nl) * K + k0 + ks * 8) = wv;
        }
        __syncthreads();
    }
}
constexpr int XP_J0 = 77 * 32, XP_J1 = XP_J0 + 8 * 32, XP_J2 = XP_J1 + 44 * 32, XP_J3 = XP_J2 + 8 * 88, XP_GU_DEFER = 352;
__device__ __forceinline__ bool xpose_deferred() { return gridDim.x == 256; }
__device__ __forceinline__ void xpose_phase(const Params& P, LAS unsigned char* lds) {
    const int G = (int)gridDim.x, bx = (int)blockIdx.x;
    if (!xpose_deferred()) { xpose_jobs(P, lds, 0, XP_J3, bx, G); return; }
    xpose_jobs(P, lds, 0, XP_J0, bx, G);
    xpose_jobs(P, lds, XP_J1 + XP_GU_DEFER, XP_J2, ((bx - XP_J0 % G) % G + G) % G, G);
}
__device__ __forceinline__ void xpose_tail_inproj(const Params& P, LAS unsigned char* lds) {
    if (xpose_deferred() && blockIdx.x >= 168) xpose_jobs(P, lds, XP_J0, XP_J1 + XP_GU_DEFER, (int)blockIdx.x - 168, 88);
}
__device__ __forceinline__ void xpose_tail_gateup(const Params& P, LAS unsigned char* lds) {
    if (xpose_deferred() && blockIdx.x >= 96) xpose_jobs(P, lds, XP_J2, XP_J3, (int)blockIdx.x - 96, 160);
}

__device__ __forceinline__ bool split_on() { return gridDim.x == 256; }
template <int WHICH> __device__ __forceinline__ void normmod_phase(const Params& P) {
    int tid = threadIdx.x; asm volatile("" : "+v"(tid)); const int w = tid >> 6, lane = tid & 63;
    const float* g = P.in[WHICH == 0 ? 14 : 21]; const float* mod = (const float*)(P.ws + WS_MOD);
    bf16_t* H = (bf16_t*)(P.ws + WS_H);
    for (int row = blockIdx.x * 8 + w; row < MT; row += gridDim.x * 8) {
        const float* src = WHICH == 0 ? (row < SEQ ? P.in[0] + (size_t)row * DM : P.in[1] + (size_t)(row - SEQ) * DM) : P.out + (size_t)row * DM;
        const int s = seq_of_row(row);
        const float* sh = mod + (size_t)s * 12288 + (WHICH == 0 ? 0 : 6144); const float* sl = sh + 2048;
        f32x4 v[8]; float ss = 0.f;
        if (WHICH == 1 && row >= SEQ && split_on()) {
            const float* pp = (const float*)(P.ws + WS_PART) + (size_t)(row - SEQ) * DM; const float* xs = P.in[1] + (size_t)(row - SEQ) * DM; const float* gt = mod + (size_t)s * 12288 + 4096;
            float* Yr = P.out + (size_t)row * DM;
#pragma unroll
            for (int j = 0; j < 8; ++j) {
                const int c = lane * 4 + 256 * j; constexpr size_t PS = (size_t)(MT - SEQ) * DM;
                const f32x4 a = ((*(const f32x4*)(pp + c) + *(const f32x4*)(pp + PS + c)) + *(const f32x4*)(pp + 2 * PS + c)) + *(const f32x4*)(pp + 3 * PS + c);
                v[j] = *(const f32x4*)(xs + c) + *(const f32x4*)(gt + c) * a; *(f32x4*)(Yr + c) = v[j];
                ss += v[j][0] * v[j][0] + v[j][1] * v[j][1] + v[j][2] * v[j][2] + v[j][3] * v[j][3];
            }
        } else {
#pragma unroll
            for (int j = 0; j < 8; ++j) { v[j] = *(const f32x4*)(src + lane * 4 + 256 * j); ss += v[j][0] * v[j][0] + v[j][1] * v[j][1] + v[j][2] * v[j][2] + v[j][3] * v[j][3]; }
        }
        ss = wave_sum(ss);
        const float rstd = rsqrtf(ss * (1.0f / DM) + 1e-6f);
#pragma unroll
        for (int j = 0; j < 8; ++j) {
            const int c = lane * 4 + 256 * j;
            const f32x4 gg = *(const f32x4*)(g + c), a = *(const f32x4*)(sl + c), b = *(const f32x4*)(sh + c);
            const f32x4 y = (v[j] * rstd * gg) * (1.0f + a) + b;
            u32x2 o; o.x = cvt_pk_bf16(y[0], y[1]); o.y = cvt_pk_bf16(y[2], y[3]);
            *(u32x2*)(H + (size_t)row * DM + c) = o;
        }
    }
}

__device__ __forceinline__ void finalnorm_phase(const Params& P) {
    int tid = threadIdx.x; asm volatile("" : "+v"(tid)); const int w = tid >> 6, lane = tid & 63;
    const float* g = P.in[11];
    for (int row = blockIdx.x * 8 + w; row < MT; row += gridDim.x * 8) {
        float* src = P.out + (size_t)row * DM;
        f32x4 v[8]; float ss = 0.f;
        if (row >= SEQ && split_on()) {
            const float* pp = (const float*)(P.ws + WS_PART) + (size_t)(row - SEQ) * DM; const float* gt = (const float*)(P.ws + WS_MOD) + (size_t)seq_of_row(row) * 12288 + 10240;
#pragma unroll
            for (int j = 0; j < 8; ++j) {
                const int c = lane * 4 + 256 * j; constexpr size_t PS = (size_t)(MT - SEQ) * DM;
                const f32x4 a = ((*(const f32x4*)(pp + c) + *(const f32x4*)(pp + PS + c)) + *(const f32x4*)(pp + 2 * PS + c)) + *(const f32x4*)(pp + 3 * PS + c);
                v[j] = *(const f32x4*)(src + c) + *(const f32x4*)(gt + c) * a;
                ss += v[j][0] * v[j][0] + v[j][1] * v[j][1] + v[j][2] * v[j][2] + v[j][3] * v[j][3];
            }
        } else {
#pragma unroll
            for (int j = 0; j < 8; ++j) { v[j] = *(const f32x4*)(src + lane * 4 + 256 * j); ss += v[j][0] * v[j][0] + v[j][1] * v[j][1] + v[j][2] * v[j][2] + v[j][3] * v[j][3]; }
        }
        ss = wave_sum(ss);
        const float rstd = rsqrtf(ss * (1.0f / DM) + 1e-6f);
#pragma unroll
        for (int j = 0; j < 8; ++j) { const int c = lane * 4 + 256 * j; *(f32x4*)(src + c) = v[j] * rstd * *(const f32x4*)(g + c); }
    }
}

__device__ __forceinline__ void ffn_seam_phase(const Params& P) {
    const float* SG = (const float*)(P.ws + WS_SIDEG); const float* SU = (const float*)(P.ws + WS_SIDEU); bf16_t* UP = (bf16_t*)(P.ws + WS_UP);
    const float* cw = P.in[23]; const float* cb = P.in[24];
    constexpr int NC4 = DFF / 4;
    int tid_ = threadIdx.x; asm volatile("" : "+v"(tid_));
    for (int task = blockIdx.x * NTHREADS + tid_; task < 255 * NC4; task += gridDim.x * NTHREADS) {
        const int k = 1 + task / NC4, f = (task % NC4) * 4;
        const f32x4 w0 = *(const f32x4*)(cw + f), w1 = *(const f32x4*)(cw + DFF + f), w2 = *(const f32x4*)(cw + 2 * DFF + f), bb = *(const f32x4*)(cb + f);
        const f32x4 xm2 = *(const f32x4*)(SG + ((size_t)(k - 1) * 4 + 0) * DFF + f), xm1 = *(const f32x4*)(SG + ((size_t)(k - 1) * 4 + 1) * DFF + f);
        const f32x4 x0 = *(const f32x4*)(SG + ((size_t)k * 4 + 2) * DFF + f), x1 = *(const f32x4*)(SG + ((size_t)k * 4 + 3) * DFF + f);
        const f32x4 u0 = *(const f32x4*)(SU + ((size_t)k * 2 + 0) * DFF + f), u1 = *(const f32x4*)(SU + ((size_t)k * 2 + 1) * DFF + f);
        f32x4 y0, y1;
#pragma unroll
        for (int q = 0; q < 4; ++q) {
            y0[q] = siluf_(fmaf(w0[q], xm2[q], fmaf(w1[q], xm1[q], fmaf(w2[q], x0[q], bb[q])))) * u0[q];
            y1[q] = siluf_(fmaf(w0[q], xm1[q], fmaf(w1[q], x0[q], fmaf(w2[q], x1[q], bb[q])))) * u1[q];
        }
        u32x2 o0, o1; o0.x = cvt_pk_bf16(y0[0], y0[1]); o0.y = cvt_pk_bf16(y0[2], y0[3]); o1.x = cvt_pk_bf16(y1[0], y1[1]); o1.y = cvt_pk_bf16(y1[2], y1[3]);
        *(u32x2*)(UP + (size_t)(64 * k) * DFF + f) = o0; *(u32x2*)(UP + (size_t)(64 * k + 1) * DFF + f) = o1;
    }
}

__device__ __forceinline__ void act_phase(const Params& P) {
    const bf16_t* GP = (const bf16_t*)(P.ws + WS_GP); bf16_t* UP = (bf16_t*)(P.ws + WS_UP);
    const float* cw = P.in[23]; const float* cb = P.in[24]; const float* st = P.in[9];
    constexpr int NCG = DFF / 8, NRB = MT / 32;
    int tid_ = threadIdx.x; asm volatile("" : "+v"(tid_));
    for (int task = blockIdx.x * NTHREADS + tid_; task < NCG * NRB; task += gridDim.x * NTHREADS) {
        const int cg = task % NCG, rb = task / NCG, f = cg * 8, m0 = rb * 32;
        float w0[8], w1[8], w2[8], bb[8], xm2[8], xm1[8];
#pragma unroll
        for (int q = 0; q < 8; ++q) { w0[q] = cw[f + q]; w1[q] = cw[DFF + f + q]; w2[q] = cw[2 * DFF + f + q]; bb[q] = cb[f + q]; }
        const bool isP = m0 < SEQ; const int t0 = isP ? m0 : ((m0 - SEQ) & 63);
        if (t0 == 0) {
            if (isP) {
#pragma unroll
                for (int q = 0; q < 8; ++q) { xm2[q] = 0.f; xm1[q] = 0.f; }
            } else {
                const float* sp = st + (size_t)((m0 - SEQ) >> 6) * 2 * DFF + f;
#pragma unroll
                for (int q = 0; q < 8; ++q) { xm2[q] = sp[q]; xm1[q] = sp[DFF + q]; }
            }
        } else {
            const u32x4 a = *(const u32x4*)(GP + (size_t)(m0 - 2) * DFF + f), b = *(const u32x4*)(GP + (size_t)(m0 - 1) * DFF + f);
            xm2[0] = bflo(a.x); xm2[1] = bfhi(a.x); xm2[2] = bflo(a.y); xm2[3] = bfhi(a.y); xm2[4] = bflo(a.z); xm2[5] = bfhi(a.z); xm2[6] = bflo(a.w); xm2[7] = bfhi(a.w);
            xm1[0] = bflo(b.x); xm1[1] = bfhi(b.x); xm1[2] = bflo(b.y); xm1[3] = bfhi(b.y); xm1[4] = bflo(b.z); xm1[5] = bfhi(b.z); xm1[6] = bflo(b.w); xm1[7] = bfhi(b.w);
        }
#pragma unroll 1
        for (int ib = 0; ib < 32; ib += 8) {
            u32x4 gq[8], uq[8];
#pragma unroll
            for (int i = 0; i < 8; ++i) { const size_t off = (size_t)(m0 + ib + i) * DFF + f; gq[i] = *(const u32x4*)(GP + off); uq[i] = *(const u32x4*)(UP + off); }
#pragma unroll
            for (int i = 0; i < 8; ++i) {
                float x0[8], uu[8], y[8];
                x0[0] = bflo(gq[i].x); x0[1] = bfhi(gq[i].x); x0[2] = bflo(gq[i].y); x0[3] = bfhi(gq[i].y); x0[4] = bflo(gq[i].z); x0[5] = bfhi(gq[i].z); x0[6] = bflo(gq[i].w); x0[7] = bfhi(gq[i].w);
                uu[0] = bflo(uq[i].x); uu[1] = bfhi(uq[i].x); uu[2] = bflo(uq[i].y); uu[3] = bfhi(uq[i].y); uu[4] = bflo(uq[i].z); uu[5] = bfhi(uq[i].z); uu[6] = bflo(uq[i].w); uu[7] = bfhi(uq[i].w);
#pragma unroll
                for (int q = 0; q < 8; ++q) { const float a = fmaf(w0[q], xm2[q], fmaf(w1[q], xm1[q], fmaf(w2[q], x0[q], bb[q]))); y[q] = siluf_(a) * uu[q]; xm2[q] = xm1[q]; xm1[q] = x0[q]; }
                u32x4 o; o.x = cvt_pk_bf16(y[0], y[1]); o.y = cvt_pk_bf16(y[2], y[3]); o.z = cvt_pk_bf16(y[4], y[5]); o.w = cvt_pk_bf16(y[6], y[7]);
                *(u32x4*)(UP + (size_t)(m0 + ib + i) * DFF + f) = o;
            }
        }
    }
}

__device__ __forceinline__ void merge_phase(const Params& P) {
    const bf16_t* OA = (const bf16_t*)(P.ws + WS_H); const bf16_t* OB = (const bf16_t*)(P.ws + WS_OB);
    const bf16_t* Z = (const bf16_t*)(P.ws + WS_Z); const bf16_t* GA = (const bf16_t*)(P.ws + WS_GA); const bf16_t* GB = (const bf16_t*)(P.ws + WS_GB);
    const float* gdn = P.in[19]; bf16_t* MIX = (bf16_t*)(P.ws + WS_H);
    const size_t total = (size_t)MT * DM / 8;
    int tid_ = threadIdx.x; asm volatile("" : "+v"(tid_));
    for (size_t task = (size_t)blockIdx.x * NTHREADS + tid_; task < total; task += (size_t)gridDim.x * NTHREADS) {
        const size_t off = task * 8; const int dv = (int)(off & 127);
        const u32x4 oa = *(const u32x4*)(OA + off), ob = *(const u32x4*)(OB + off), z = *(const u32x4*)(Z + off), ga = *(const u32x4*)(GA + off), gb = *(const u32x4*)(GB + off);
        float b[8] = {bflo(ob.x), bfhi(ob.x), bflo(ob.y), bfhi(ob.y), bflo(ob.z), bfhi(ob.z), bflo(ob.w), bfhi(ob.w)};
        float ss = 0.f;
#pragma unroll
        for (int q = 0; q < 8; ++q) ss += b[q] * b[q];
        ss += __shfl_xor(ss, 1); ss += __shfl_xor(ss, 2); ss += __shfl_xor(ss, 4); ss += __shfl_xor(ss, 8);
        const float rstd = rsqrtf(ss * (1.0f / 128.0f) + 1e-6f);
        const float a[8] = {bflo(oa.x), bfhi(oa.x), bflo(oa.y), bfhi(oa.y), bflo(oa.z), bfhi(oa.z), bflo(oa.w), bfhi(oa.w)};
        const float zz[8] = {bflo(z.x), bfhi(z.x), bflo(z.y), bfhi(z.y), bflo(z.z), bfhi(z.z), bflo(z.w), bfhi(z.w)};
        const float g1[8] = {bflo(ga.x), bfhi(ga.x), bflo(ga.y), bfhi(ga.y), bflo(ga.z), bfhi(ga.z), bflo(ga.w), bfhi(ga.w)};
        const float g2[8] = {bflo(gb.x), bfhi(gb.x), bflo(gb.y), bfhi(gb.y), bflo(gb.z), bfhi(gb.z), bflo(gb.w), bfhi(gb.w)};
        float y[8];
#pragma unroll
        for (int q = 0; q < 8; ++q) y[q] = g1[q] * a[q] + g2[q] * (b[q] * rstd * gdn[dv + q] * zz[q]);
        u32x4 o; o.x = cvt_pk_bf16(y[0], y[1]); o.y = cvt_pk_bf16(y[2], y[3]); o.z = cvt_pk_bf16(y[4], y[5]); o.w = cvt_pk_bf16(y[6], y[7]);
        *(u32x4*)(MIX + off) = o;
    }
}
__device__ __forceinline__ void d1_phase(const Params& P, LAS unsigned char* lds) {
    const int grp = threadIdx.x >> 8;
    LAS unsigned char* base = lds + grp * 53248;
    LAS unsigned char* Kraw = base;
    LAS unsigned char* Qraw = base + 16384;
    LAS float* Ml = (LAS float*)(base + 32768);
    LAS float* GC = (LAS float*)(base + 49152); LAS float* BETA = GC + 64; LAS float* EG = GC + 128; LAS float* EKD = GC + 192; LAS float* RK = GC + 256; LAS float* RQ = GC + 320;
    const bf16_t* QKVB = (const bf16_t*)(P.ws + WS_QKVB);
    const float* ABp = (const float*)(P.ws + WS_AB); const float* BBp = (const float*)(P.ws + WS_BB); float* GL = (float*)(P.ws + WS_GL);
    const float* cw = P.in[16]; const float* stc = P.in[7];
    for (int ub = blockIdx.x * 2; ub < NUNIT; ub += gridDim.x * 2) {
        int tid = threadIdx.x; asm volatile("" : "+v"(tid));
        const int tg = tid & 255, wg4 = __builtin_amdgcn_readfirstlane((tid >> 6) & 3), lane = tid & 63, r32 = lane & 31, hi = lane >> 5;
        const int u = ub + grp, sq = u >> 4, h = u & 15;
        const bool isS = sq >= 256; const int bsm = sq - 256;
        const int m0 = isS ? SEQ + 64 * bsm : 64 * sq;
        unsigned char* ublk = unit_ptr(P, u);
        if (tg < 64) {
            const int t = tg;
            const float ab = ABp[(size_t)(m0 + t) * 16 + h], bb = BBp[(size_t)(m0 + t) * 16 + h];
            const float x = ab + P.in[18][h];
            const float sp = x > 20.f ? x : log1pf(expf(x));
            float gcv = -expf(P.in[17][h]) * sp;
#pragma unroll
            for (int off = 1; off < 64; off <<= 1) { const float v = __shfl_up(gcv, off); if (lane >= off) gcv += v; }
            const float gcl = __shfl(gcv, 63);
            GC[t] = gcv; BETA[t] = 1.0f / (1.0f + expf(-bb)); EG[t] = expf(gcv); EKD[t] = expf(gcl - gcv);
            if (t == 63) GL[u] = expf(gcv);
        }
        float xr[64];
        {
            const int col = (wg4 < 2 ? 4096 + h * 128 + wg4 * 64 : 2048 + h * 128 + (wg4 - 2) * 64) + lane;
            const float w0 = cw[col], w1 = cw[CONVB + col], w2 = cw[2 * CONVB + col], w3 = cw[3 * CONVB + col];
            float xm3, xm2, xm1;
            if (isS) { const float* sp = stc + (size_t)bsm * 3 * CONVB + col; xm3 = sp[0]; xm2 = sp[CONVB]; xm1 = sp[2 * CONVB]; }
            else if (sq == 0) { xm3 = 0.f; xm2 = 0.f; xm1 = 0.f; }
            else { const bf16_t* pp = QKVB + (size_t)(m0 - 3) * CONVB + col; xm3 = bf2f(pp[0]); xm2 = bf2f(pp[CONVB]); xm1 = bf2f(pp[2 * CONVB]); }
            const bf16_t* px = QKVB + (size_t)m0 * CONVB + col;
            bf16_t xin[64];
#pragma unroll
            for (int t = 0; t < 64; ++t) xin[t] = px[(size_t)t * CONVB];
#pragma unroll
            for (int t = 0; t < 64; ++t) {
                const float x = bf2f(xin[t]);
                const float y = fmaf(w0, xm3, fmaf(w1, xm2, fmaf(w2, xm1, w3 * x)));
                xr[t] = siluf_(y);
                xm3 = xm2; xm2 = xm1; xm1 = x;
            }
            asm volatile("" ::: "memory");
            if (wg4 >= 2) {
                const int dk = (wg4 - 2) * 64 + lane;
#pragma unroll
                for (int t = 0; t < 64; ++t) *(LAS bf16_t*)(Kraw + t * 256 + ((((dk >> 3) ^ (t & 15))) << 4) + (dk & 7) * 2) = f2bf(xr[t]);
            }
        }
        {
            const int dq = tg & 127, half = tg >> 7, col = h * 128 + dq, ts = 32 * half;
            const float w0 = cw[col], w1 = cw[CONVB + col], w2 = cw[2 * CONVB + col], w3 = cw[3 * CONVB + col];
            float xm3, xm2, xm1;
            if (half == 0 && isS) { const float* sp = stc + (size_t)bsm * 3 * CONVB + col; xm3 = sp[0]; xm2 = sp[CONVB]; xm1 = sp[2 * CONVB]; }
            else if (half == 0 && sq == 0) { xm3 = 0.f; xm2 = 0.f; xm1 = 0.f; }
            else { const bf16_t* pp = QKVB + (size_t)(m0 + ts - 3) * CONVB + col; xm3 = bf2f(pp[0]); xm2 = bf2f(pp[CONVB]); xm1 = bf2f(pp[2 * CONVB]); }
            const bf16_t* px = QKVB + (size_t)(m0 + ts) * CONVB + col;
            bf16_t xin[32];
#pragma unroll
            for (int i = 0; i < 32; ++i) xin[i] = px[(size_t)i * CONVB];
#pragma unroll
            for (int i = 0; i < 32; ++i) {
                const int t = ts + i;
                const float x = bf2f(xin[i]);
                const float y = fmaf(w0, xm3, fmaf(w1, xm2, fmaf(w2, xm1, w3 * x)));
                *(LAS bf16_t*)(Qraw + t * 256 + ((((dq >> 3) ^ (t & 15))) << 4) + (dq & 7) * 2) = f2bf(siluf_(y));
                xm3 = xm2; xm2 = xm1; xm1 = x;
            }
            asm volatile("" ::: "memory");
        }
        __syncthreads();
        {
            const int row = tg >> 2, qt = tg & 3; float sk = 0.f, sq2 = 0.f;
#pragma unroll
            for (int c = 0; c < 4; ++c) {
                const int pc = ((4 * qt + c) ^ (row & 15)) << 4;
                const u32x4 a = *(const LAS u32x4*)(Kraw + row * 256 + pc), b = *(const LAS u32x4*)(Qraw + row * 256 + pc);
                const float ak[8] = {bflo(a.x), bfhi(a.x), bflo(a.y), bfhi(a.y), bflo(a.z), bfhi(a.z), bflo(a.w), bfhi(a.w)};
                const float bq[8] = {bflo(b.x), bfhi(b.x), bflo(b.y), bfhi(b.y), bflo(b.z), bfhi(b.z), bflo(b.w), bfhi(b.w)};
#pragma unroll
                for (int q = 0; q < 8; ++q) { sk += ak[q] * ak[q]; sq2 += bq[q] * bq[q]; }
            }
            sk += __shfl_xor(sk, 1); sk += __shfl_xor(sk, 2); sq2 += __shfl_xor(sq2, 1); sq2 += __shfl_xor(sq2, 2);
            if (qt == 0) { RK[row] = rsqrtf(sk + 1e-6f); RQ[row] = rsqrtf(sq2 + 1e-6f) * 0.08838834764831845f; }
        }
        __syncthreads();
        if (wg4 < 3) {
            const int ti = wg4 == 0 ? 0 : 1, tj = wg4 == 2 ? 1 : 0;
            const int ri = 32 * ti + r32, rj = 32 * tj + r32;
            f32x16 accK = {}, accQ = {};
#pragma unroll
            for (int ks = 0; ks < 8; ++ks) {
                const int ch = 2 * ks + hi;
                const bf16x8 ki = *(const LAS bf16x8*)(Kraw + ri * 256 + ((ch ^ (ri & 15)) << 4));
                const bf16x8 kj = *(const LAS bf16x8*)(Kraw + rj * 256 + ((ch ^ (rj & 15)) << 4));
                const bf16x8 qi = *(const LAS bf16x8*)(Qraw + ri * 256 + ((ch ^ (ri & 15)) << 4));
                accK = __builtin_amdgcn_mfma_f32_32x32x16_bf16(ki, kj, accK, 0, 0, 0);
                accQ = __builtin_amdgcn_mfma_f32_32x32x16_bf16(kj, qi, accQ, 0, 0, 0);
            }
            {
                const int j = rj; const float rkj = RK[j], gcj = GC[j];
#pragma unroll
                for (int r = 0; r < 16; ++r) {
                    const int i = 32 * ti + crow(r, hi);
                    const float v = i > j ? BETA[i] * RK[i] * rkj * accK[r] * __expf(fminf(GC[i] - gcj, 0.f)) : 0.f;
                    Ml[i * 64 + j] = v;
                }
            }
            {
                const int i = ri; const float rqi = RQ[i], gci = GC[i];
                unsigned char* Ab = ublk + UB_A + i * RA;
#pragma unroll
                for (int g = 0; g < 4; ++g) {
                    float v[4];
#pragma unroll
                    for (int e = 0; e < 4; ++e) { const int j = 32 * tj + 8 * g + 4 * hi + e; v[e] = i >= j ? rqi * RK[j] * accQ[4 * g + e] * __expf(fminf(gci - GC[j], 0.f)) : 0.f; }
                    u32x2 o; o.x = cvt_pk_bf16(v[0], v[1]); o.y = cvt_pk_bf16(v[2], v[3]);
                    *(u32x2*)(Ab + (4 * tj + g) * 16 + hi * 8) = o;
                }
            }
        } else {
            unsigned char* Ab = ublk + UB_A + r32 * RA;
#pragma unroll
            for (int g = 0; g < 4; ++g) { u32x2 o; o.x = 0u; o.y = 0u; *(u32x2*)(Ab + (4 + g) * 16 + hi * 8) = o; }
        }
        __syncthreads();
        if (wg4 >= 2) {
            const int dk = (wg4 - 2) * 64 + lane;
            unsigned char* kd = ublk + UB_KD + dk * RA;
#pragma unroll
            for (int c = 0; c < 8; ++c) {
                float v[8];
#pragma unroll
                for (int q = 0; q < 8; ++q) { const int t = 8 * c + q; v[q] = xr[t] * RK[t] * EKD[t]; }
                u32x4 o; o.x = cvt_pk_bf16(v[0], v[1]); o.y = cvt_pk_bf16(v[2], v[3]); o.z = cvt_pk_bf16(v[4], v[5]); o.w = cvt_pk_bf16(v[6], v[7]);
                *(u32x2*)(kd + c * 16) = u32x2{o.x, o.y}; *(u32x2*)(kd + c * 16 + 8) = u32x2{o.z, o.w};
            }
#pragma unroll
            for (int t = 0; t < 64; ++t) xr[t] *= RK[t] * BETA[t] * EG[t];
        } else {
#pragma unroll
            for (int t = 0; t < 64; ++t) xr[t] *= BETA[t];
        }
#pragma unroll
        for (int ib = 0; ib < 64; ib += 4) {
            int mi[4];
#pragma unroll
            for (int c = 0; c < 4; ++c) mi[c] = __float_as_int(Ml[(ib + c) * 64 + lane]);
#pragma unroll
            for (int c = 0; c < 4; ++c) {
                const int i = ib + c;
                float a0 = 0.f, a1 = 0.f;
#pragma unroll
                for (int j0 = 0; j0 < i; j0 += 4) {
                    float mv[4];
#pragma unroll
                    for (int k = 0; k < 4; ++k) if (j0 + k < i) mv[k] = __int_as_float(__builtin_amdgcn_readlane(mi[c], j0 + k));
#pragma unroll
                    for (int k = 0; k < 4; ++k) if (j0 + k < i) { if (k & 1) a1 = fmaf(mv[k], xr[j0 + k], a1); else a0 = fmaf(mv[k], xr[j0 + k], a0); }
                }
                if (i > 0) xr[i] -= (a0 + a1);
            }
            asm volatile("" ::: "memory");
        }
        if (wg4 < 2) {
            bf16_t* U = (bf16_t*)(ublk + UB_U) + wg4 * 64 + lane;
#pragma unroll
            for (int t = 0; t < 64; ++t) U[t * 128] = f2bf(xr[t]);
        } else {
            const int dk = (wg4 - 2) * 64 + lane;
#pragma unroll
            for (int t = 0; t < 64; ++t) *(bf16_t*)(ublk + UB_W + t * RW + dk * 2) = f2bf(xr[t]);
        }
        {
            const int row = tg >> 2, qt = tg & 3; const float s = RQ[row] * EG[row];
#pragma unroll
            for (int c = 0; c < 4; ++c) {
                const int pc = ((4 * qt + c) ^ (row & 15)) << 4;
                const u32x4 b = *(const LAS u32x4*)(Qraw + row * 256 + pc);
                u32x4 o; o.x = cvt_pk_bf16(bflo(b.x) * s, bfhi(b.x) * s); o.y = cvt_pk_bf16(bflo(b.y) * s, bfhi(b.y) * s); o.z = cvt_pk_bf16(bflo(b.z) * s, bfhi(b.z) * s); o.w = cvt_pk_bf16(bflo(b.w) * s, bfhi(b.w) * s);
                { unsigned char* qp = ublk + UB_QG + row * RW + (4 * qt + c) * 16; *(u32x2*)qp = u32x2{o.x, o.y}; *(u32x2*)(qp + 8) = u32x2{o.z, o.w}; }
            }
        }
        __syncthreads();
    }
}
__device__ __forceinline__ bf16x8 pack_acc8(const f32x16& a, int s) {
    u32x4 w; w.x = cvt_pk_bf16(a[8 * s + 0], a[8 * s + 1]); w.y = cvt_pk_bf16(a[8 * s + 2], a[8 * s + 3]); w.z = cvt_pk_bf16(a[8 * s + 4], a[8 * s + 5]); w.w = cvt_pk_bf16(a[8 * s + 6], a[8 * s + 7]);
    return *reinterpret_cast<bf16x8*>(&w);
}
template <int ROWB> __device__ __forceinline__ bf16x8 ld_afrag(const LAS unsigned char* rowp, int k0) {
    const u32x2 a = *(const LAS u32x2*)(rowp + k0 * 2);
    const u32x2 b = *(const LAS u32x2*)(rowp + k0 * 2 + 16);
    u32x4 w; w.x = a.x; w.y = a.y; w.z = b.x; w.w = b.y; return *reinterpret_cast<bf16x8*>(&w);
}
__device__ __forceinline__ void d2_task(const Params& P, LAS unsigned char* lds, int sq0, int nsteps, int h) {
    int tid_ = threadIdx.x; asm volatile("" : "+v"(tid_));
    const int tid = tid_, cw = __builtin_amdgcn_readfirstlane(tid >> 6);
    const bool isS = sq0 >= 256;
    {
        const u32x4* src = (const u32x4*)unit_ptr(P, sq0 * 16 + h);
        for (int i = tid; i < UNITB / 16; i += 512) *(LAS u32x4*)(lds + (size_t)i * 16) = src[i];
    }
    __syncthreads();
    if (cw >= 4) {
        for (int n = 0; n < nsteps; ++n) {
            if (n + 1 < nsteps) {
                const u32x4* src = (const u32x4*)unit_ptr(P, (sq0 + n + 1) * 16 + h);
                LAS unsigned char* dst = lds + ((n + 1) & 1) * UNITB;
                int lt = tid - 256; asm volatile("" : "+v"(lt));
                u32x4 pre[19];
#pragma unroll
                for (int i = 0; i < 19; ++i) pre[i] = src[min(lt + 256 * i, UNITB / 16 - 1)];
#pragma unroll
                for (int i = 0; i < 19; ++i) *(LAS u32x4*)(dst + (size_t)min(lt + 256 * i, UNITB / 16 - 1) * 16) = pre[i];
            }
            __syncthreads();
        }
        return;
    }
    const int d0 = 32 * cw;
    const float* GL = (const float*)(P.ws + WS_GL);
    bf16_t* OB = (bf16_t*)(P.ws + WS_OB);
    f32x16 S[4];
    {
        const int lane = tid & 63, r32 = lane & 31, hi = lane >> 5;
        if (isS) {
            const float* sp = P.in[8] + (((size_t)(sq0 - 256) * 16 + h) * 128 + 4 * hi) * 128 + d0 + r32;
#pragma unroll
            for (int t = 0; t < 4; ++t)
#pragma unroll
                for (int r = 0; r < 16; ++r) S[t][r] = sp[(size_t)(32 * t + (r & 3) + 8 * (r >> 2)) * 128];
        } else {
#pragma unroll
            for (int t = 0; t < 4; ++t) S[t] = f32x16{};
        }
    }
    for (int n = 0; n < nsteps; ++n) {
        const int sq = sq0 + n, u = sq * 16 + h;
        int lo = tid & 63; asm volatile("" : "+v"(lo));
        const int r32 = lo & 31, hi = lo >> 5;
        const LAS unsigned char* blk = lds + (n & 1) * UNITB;
        const LAS unsigned char* Wi = blk + UB_W + r32 * RW + 8 * hi; const LAS unsigned char* QGi = blk + UB_QG + r32 * RW + 8 * hi;
        const LAS unsigned char* Ai = blk + UB_A + r32 * RA + 8 * hi; const LAS unsigned char* KDi = blk + UB_KD + r32 * RA + 8 * hi;
        const LAS bf16_t* Ui = (const LAS bf16_t*)(blk + UB_U);
        const float gl = GL[u];
        const int m0 = sq < 256 ? 64 * sq : SEQ + 64 * (sq - 256);
        bf16x8 Sb[4][2];
#pragma unroll
        for (int t = 0; t < 4; ++t) { Sb[t][0] = pack_acc8(S[t], 0); Sb[t][1] = pack_acc8(S[t], 1); }
        bf16x8 fa[8], fb[8];
        f32x16 aW[2] = {f32x16{}, f32x16{}}, aQ[2] = {f32x16{}, f32x16{}};
#pragma unroll
        for (int i = 0; i < 8; ++i) fa[i] = ld_afrag<RW>(Wi, 16 * i);
#pragma unroll
        for (int i = 0; i < 8; ++i) fb[i] = ld_afrag<RW>(Wi + 32 * RW, 16 * i);
        __builtin_amdgcn_sched_barrier(0);
#pragma unroll
        for (int i = 0; i < 8; ++i) aW[0] = __builtin_amdgcn_mfma_f32_32x32x16_bf16(fa[i], Sb[i >> 1][i & 1], aW[0], 0, 0, 0);
#pragma unroll
        for (int i = 0; i < 8; ++i) fa[i] = ld_afrag<RW>(QGi, 16 * i);
        __builtin_amdgcn_sched_barrier(0);
#pragma unroll
        for (int i = 0; i < 8; ++i) aW[1] = __builtin_amdgcn_mfma_f32_32x32x16_bf16(fb[i], Sb[i >> 1][i & 1], aW[1], 0, 0, 0);
#pragma unroll
        for (int i = 0; i < 8; ++i) fb[i] = ld_afrag<RW>(QGi + 32 * RW, 16 * i);
        __builtin_amdgcn_sched_barrier(0);
#pragma unroll
        for (int i = 0; i < 8; ++i) aQ[0] = __builtin_amdgcn_mfma_f32_32x32x16_bf16(fa[i], Sb[i >> 1][i & 1], aQ[0], 0, 0, 0);
#pragma unroll
        for (int i = 0; i < 2; ++i) fa[i] = ld_afrag<RA>(Ai, 16 * i);
#pragma unroll
        for (int i = 0; i < 4; ++i) fa[2 + i] = ld_afrag<RA>(Ai + 32 * RA, 16 * i);
        __builtin_amdgcn_sched_barrier(0);
#pragma unroll
        for (int i = 0; i < 8; ++i) aQ[1] = __builtin_amdgcn_mfma_f32_32x32x16_bf16(fb[i], Sb[i >> 1][i & 1], aQ[1], 0, 0, 0);
#pragma unroll
        for (int i = 0; i < 8; ++i) fb[i] = ld_afrag<RA>(KDi + 32 * (i >> 2) * RA, 16 * (i & 3));
        bf16x8 Vb[2][2];
#pragma unroll
        for (int ct = 0; ct < 2; ++ct) {
#pragma unroll
            for (int r = 0; r < 16; ++r) aW[ct][r] = bf2f(Ui[(32 * ct + crow(r, hi)) * 128 + d0 + r32]) - aW[ct][r];
            Vb[ct][0] = pack_acc8(aW[ct], 0); Vb[ct][1] = pack_acc8(aW[ct], 1);
        }
#pragma unroll
        for (int t = 0; t < 4; ++t)
#pragma unroll
            for (int r = 0; r < 16; ++r) S[t][r] *= gl;
        __builtin_amdgcn_sched_barrier(0);
#pragma unroll
        for (int i = 0; i < 2; ++i) aQ[0] = __builtin_amdgcn_mfma_f32_32x32x16_bf16(fa[i], Vb[0][i], aQ[0], 0, 0, 0);
#pragma unroll
        for (int i = 0; i < 4; ++i) aQ[1] = __builtin_amdgcn_mfma_f32_32x32x16_bf16(fa[2 + i], Vb[i >> 1][i & 1], aQ[1], 0, 0, 0);
#pragma unroll
        for (int i = 0; i < 8; ++i) fa[i] = ld_afrag<RA>(KDi + 32 * (2 + (i >> 2)) * RA, 16 * (i & 3));
        __builtin_amdgcn_sched_barrier(0);
#pragma unroll
        for (int i = 0; i < 8; ++i) S[i >> 2] = __builtin_amdgcn_mfma_f32_32x32x16_bf16(fb[i], Vb[(i >> 1) & 1][i & 1], S[i >> 2], 0, 0, 0);
        __builtin_amdgcn_sched_barrier(0);
#pragma unroll
        for (int i = 0; i < 8; ++i) S[2 + (i >> 2)] = __builtin_amdgcn_mfma_f32_32x32x16_bf16(fa[i], Vb[(i >> 1) & 1][i & 1], S[2 + (i >> 2)], 0, 0, 0);
#pragma unroll
        for (int co = 0; co < 2; ++co) {
            {
                LAS unsigned char* ot = (LAS unsigned char*)blk + UB_U + d0 * 2 + (32 * co) * 256;
#pragma unroll
                for (int r = 0; r < 16; ++r) *(LAS bf16_t*)(ot + crow(r, hi) * 256 + r32 * 2) = f2bf(aQ[co][r]);
                asm volatile("" ::: "memory");
#pragma unroll
                for (int it = 0; it < 2; ++it) { const int row = it * 16 + (lo >> 2);
                    const u32x4 v = *(const LAS u32x4*)(ot + row * 256 + (lo & 3) * 16);
                    *(u32x4*)(OB + (size_t)(m0 + 32 * co + row) * DM + h * 128 + d0 + 8 * (lo & 3)) = v; }
                asm volatile("" ::: "memory");
            }
        }
        __syncthreads();
    }
    {
        const int lane = tid & 63, r32 = lane & 31, hi = lane >> 5;
        const int sl = sq0 + nsteps - 1;
        float* dst = P.out + (isS ? O_DS + ((size_t)(sl - 256) * 16 + h) * 16384 : O_DP + (size_t)h * 16384);
#pragma unroll
        for (int t = 0; t < 4; ++t)
#pragma unroll
            for (int r = 0; r < 16; ++r) dst[(size_t)(32 * t + crow(r, hi)) * 128 + d0 + r32] = S[t][r];
    }
}
__device__ __forceinline__ void d2_phase(const Params& P, LAS unsigned char* lds) {
    const int G = gridDim.x, bx = blockIdx.x;
    for (int k = 0;; ++k) {
        int sq0, nst, h;
        if (G <= 16) { const int T = bx + k * G; if (T >= 528) break; if (T < 16) { sq0 = 0; nst = 256; h = T; } else { sq0 = 256 + ((T - 16) >> 4); nst = 1; h = (T - 16) & 15; } }
        else if (bx < 16) { if (k > 0) break; sq0 = 0; nst = 256; h = bx; }
        else { const int i = bx - 16 + k * (G - 16); if (i >= 512) break; sq0 = 256 + (i >> 4); nst = 1; h = i & 15; }
        d2_task(P, lds, sq0, nst, h);
    }
}
constexpr int IX_QROW = 144;
constexpr int IX_HS = 1028, IX_MS = 516;
constexpr int IX_HIST = 36864, IX_SM = IX_HIST + 16 * IX_HS * 4, IX_MASK = IX_SM + 512, IX_CAP = 512;
constexpr int IX_SCR_N32 = 392;
constexpr size_t IX_SCR = (size_t)IX_SCR_N32 * 2048, IX_SCR_A = WS_QKVB + 75497472, IX_SCR_NA = 188, IX_SCR_B = WS_END;
constexpr size_t WS_END2 = IX_SCR_B + (240 - IX_SCR_NA) * IX_SCR;
static_assert(IX_SCR_A + IX_SCR_NA * IX_SCR <= WS_Z, "key scratch overlaps z");
__device__ __forceinline__ unsigned lds_add(LAS unsigned* p, unsigned v) { return __hip_atomic_fetch_add(p, v, __ATOMIC_RELAXED, __HIP_MEMORY_SCOPE_WORKGROUP); }
__device__ __forceinline__ void lds_or(LAS unsigned* p, unsigned v) { (void)__hip_atomic_fetch_or(p, v, __ATOMIC_RELAXED, __HIP_MEMORY_SCOPE_WORKGROUP); }
__device__ __forceinline__ float relu_(float x) { return __int_as_float(max(__float_as_int(x), 0)); }
__device__ __forceinline__ unsigned ord_key(float x) { const unsigned u = __float_as_uint(x); return (u & 0x80000000u) ? ~u : (u | 0x80000000u); }

template <int PASS> __device__ __forceinline__ void ix_pass(const int kb, LAS unsigned char* lds, const bf16_t* KI, int n32, const float (&wv)[8], int w, int lane, u32x4* kcache = nullptr, const int pbeg = 0) {
    const int r32 = lane & 31, hi = lane >> 5, q = lane & 15, hp = (lane >> 4) & 1;
    LAS unsigned* hist = (LAS unsigned*)(lds + IX_HIST) + q * IX_HS;
    LAS unsigned* mst = (LAS unsigned*)(lds + IX_MASK) + q * IX_MS;
    LAS unsigned long long* cand = (LAS unsigned long long*)(lds + IX_HIST) + q * IX_CAP;
    const int sh = 32 - kb;
    LAS unsigned* sm = (LAS unsigned*)(lds + IX_SM);
    const unsigned prefix = sm[q]; const unsigned rem = sm[16 + q];
    const int np = n32 >> 1;
    bf16x8 A0[4], A1[4];
    if (pbeg + w < np) {
        const bf16_t* kp = KI + (size_t)(64 * (pbeg + w) + r32) * 64 + 8 * hi;
#pragma unroll
        for (int kk = 0; kk < 4; ++kk) { A0[kk] = *(const bf16x8*)(kp + 16 * kk); A1[kk] = *(const bf16x8*)(kp + 32 * 64 + 16 * kk); }
    }
    for (int pi = pbeg + w; pi < np; pi += 8) {
        bf16x8 N0[4], N1[4];
        {
            const int pn = pi + 8 < np ? pi + 8 : pi;
            const bf16_t* kp = KI + (size_t)(64 * pn + r32) * 64 + 8 * hi;
#pragma unroll
            for (int kk = 0; kk < 4; ++kk) { N0[kk] = *(const bf16x8*)(kp + 16 * kk); N1[kk] = *(const bf16x8*)(kp + 32 * 64 + 16 * kk); }
        }
        f32x16 S0 = {}, S1 = {};
        f32x16 a0 = {}, a1 = {};
        bf16x8 Bq[2][4];
#pragma unroll
        for (int kk = 0; kk < 4; ++kk) Bq[0][kk] = *(const LAS bf16x8*)(lds + (hp * 16 + q) * IX_QROW + (2 * kk + hi) * 16);
#pragma unroll
        for (int kk = 0; kk < 4; ++kk) Bq[1][kk] = *(const LAS bf16x8*)(lds + ((2 + hp) * 16 + q) * IX_QROW + (2 * kk + hi) * 16);
#pragma unroll
        for (int kk = 0; kk < 4; ++kk) {
            a0 = __builtin_amdgcn_mfma_f32_32x32x16_bf16(A0[kk], Bq[0][kk], a0, 0, 0, 0);
            a1 = __builtin_amdgcn_mfma_f32_32x32x16_bf16(A1[kk], Bq[0][kk], a1, 0, 0, 0);
        }
#pragma unroll
        for (int hh = 0; hh < 8; ++hh) {
            f32x16 n0 = {}, n1 = {};
            if (hh < 7) {
#pragma unroll
                for (int kk = 0; kk < 4; ++kk) {
                    n0 = __builtin_amdgcn_mfma_f32_32x32x16_bf16(A0[kk], Bq[(hh + 1) & 1][kk], n0, 0, 0, 0);
                    n1 = __builtin_amdgcn_mfma_f32_32x32x16_bf16(A1[kk], Bq[(hh + 1) & 1][kk], n1, 0, 0, 0);
                }
            }
            if (hh < 6) {
#pragma unroll
                for (int kk = 0; kk < 4; ++kk) Bq[hh & 1][kk] = *(const LAS bf16x8*)(lds + ((2 * (hh + 2) + hp) * 16 + q) * IX_QROW + (2 * kk + hi) * 16);
            }
#pragma unroll
            for (int r = 0; r < 16; r += 2) {
                const f32x2 w2 = {wv[hh], wv[hh]};
                const f32x2 m0 = {relu_(a0[r]), relu_(a0[r + 1])}, m1 = {relu_(a1[r]), relu_(a1[r + 1])};
                const f32x2 t0 = __builtin_elementwise_fma(m0, w2, (f32x2){S0[r], S0[r + 1]}), t1 = __builtin_elementwise_fma(m1, w2, (f32x2){S1[r], S1[r + 1]});
                S0[r] = t0[0]; S0[r + 1] = t0[1]; S1[r] = t1[0]; S1[r + 1] = t1[1];
            }
            if (hh < 7) {
#pragma unroll
                for (int g = 0; g < 8; ++g) { __builtin_amdgcn_sched_group_barrier(0x008, 1, 0); __builtin_amdgcn_sched_group_barrier(0x002, 6, 0); }
            }
#pragma unroll
            for (int r = 0; r < 16; ++r) { asm volatile("" : "+v"(S0[r])); asm volatile("" : "+v"(S1[r])); }
            a0 = n0; a1 = n1;
        }
        unsigned bits0 = 0u, bits1 = 0u; u32x4 kq0 = {0u, 0u, 0u, 0u}, kq1 = {0u, 0u, 0u, 0u};
#pragma unroll
        for (int r = 0; r < 8; ++r) {
            const auto x0 = __builtin_amdgcn_permlane16_swap(__float_as_uint(S0[r]), __float_as_uint(S0[8 + r]), false, false);
            const auto x1 = __builtin_amdgcn_permlane16_swap(__float_as_uint(S1[r]), __float_as_uint(S1[8 + r]), false, false);
            const float s0 = __uint_as_float(x0[0]) + __uint_as_float(x0[1]), s1 = __uint_as_float(x1[0]) + __uint_as_float(x1[1]);
            const unsigned k0 = ord_key(s0), k1 = ord_key(s1);
            const int rowbit = (r & 3) + 8 * (r >> 2) + 16 * hp + 4 * hi;
            if (PASS == 0 && kcache && pi < IX_SCR_N32 / 2) { kq0[r & 3] = k0; kq1[r & 3] = k1;
                if ((r & 3) == 3) { kcache[((size_t)pi * 4 + (r >> 2)) * 64 + lane] = kq0; kcache[((size_t)pi * 4 + 2 + (r >> 2)) * 64 + lane] = kq1; } }
            if (PASS == 0) {
                const unsigned b0 = k0 >> 21, b1 = k1 >> 21;
                lds_add(&hist[b0 >> 1], 1u << (16 * (b0 & 1))); lds_add(&hist[b1 >> 1], 1u << (16 * (b1 & 1)));
            } else if (PASS == 1) {
                const unsigned b0 = (k0 >> 10) & 2047u, b1 = (k1 >> 10) & 2047u;
                if ((k0 >> 21) == prefix) lds_add(&hist[b0 >> 1], 1u << (16 * (b0 & 1)));
                if ((k1 >> 21) == prefix) lds_add(&hist[b1 >> 1], 1u << (16 * (b1 & 1)));
            } else if (PASS == 2) {
                const unsigned b0 = k0 & 1023u, b1 = k1 & 1023u;
                if ((k0 >> 10) == prefix) lds_add(&hist[b0 >> 1], 1u << (16 * (b0 & 1)));
                if ((k1 >> 10) == prefix) lds_add(&hist[b1 >> 1], 1u << (16 * (b1 & 1)));
            } else {
                const unsigned h0 = kb == 32 ? k0 : (k0 >> sh), h1 = kb == 32 ? k1 : (k1 >> sh);
                bool sel0 = h0 > prefix, sel1 = h1 > prefix;
                if (kb == 32) {
                    if (h0 == prefix) sel0 = lds_add(&sm[32 + q], 1u) < rem;
                    if (h1 == prefix) sel1 = lds_add(&sm[32 + q], 1u) < rem;
                } else {
                    if (h0 == prefix) { const unsigned sl = lds_add(&sm[64 + q], 1u); if (sl < (unsigned)IX_CAP) cand[sl] = ((unsigned long long)k0 << 16) | (unsigned)(0xffff - (64 * pi + rowbit)); }
                    if (h1 == prefix) { const unsigned sl = lds_add(&sm[64 + q], 1u); if (sl < (unsigned)IX_CAP) cand[sl] = ((unsigned long long)k1 << 16) | (unsigned)(0xffff - (64 * pi + 32 + rowbit)); }
                }
                bits0 |= sel0 ? (1u << rowbit) : 0u; bits1 |= sel1 ? (1u << rowbit) : 0u;
            }
        }
        if (PASS == 3) { lds_or(&mst[2 * pi], bits0); lds_or(&mst[2 * pi + 1], bits1); }
#pragma unroll
        for (int kk = 0; kk < 4; ++kk) { A0[kk] = N0[kk]; A1[kk] = N1[kk]; }
    }
}
__device__ __forceinline__ void ix_pass_cached(const int kb, LAS unsigned char* lds, int n32, int w, int lane, const u32x4* kcache) {
    const int hi = lane >> 5, q = lane & 15, hp = (lane >> 4) & 1;
    LAS unsigned* mst = (LAS unsigned*)(lds + IX_MASK) + q * IX_MS;
    LAS unsigned long long* cand = (LAS unsigned long long*)(lds + IX_HIST) + q * IX_CAP;
    const int sh = 32 - kb;
    LAS unsigned* sm = (LAS unsigned*)(lds + IX_SM);
    const unsigned prefix = sm[q]; const unsigned rem = sm[16 + q];
    const int np = min(n32, IX_SCR_N32) >> 1;
    const u32x4* kc = kcache + lane;
    u32x4 c0[4], c1[4];
    { const int p0 = w < np ? w : 0, p1 = w + 8 < np ? w + 8 : p0;
#pragma unroll
      for (int j = 0; j < 4; ++j) { c0[j] = kc[((size_t)p0 * 4 + j) * 64]; c1[j] = kc[((size_t)p1 * 4 + j) * 64]; } }
    for (int pi = w; pi < np; pi += 8) {
        u32x4 c2[4];
        { const int pn = pi + 16 < np ? pi + 16 : pi;
#pragma unroll
          for (int j = 0; j < 4; ++j) c2[j] = kc[((size_t)pn * 4 + j) * 64]; }
        unsigned bits0 = 0u, bits1 = 0u;
#pragma unroll
        for (int r = 0; r < 8; ++r) {
            const unsigned k0 = c0[r >> 2][r & 3], k1 = c0[2 + (r >> 2)][r & 3];
            const int rowbit = (r & 3) + 8 * (r >> 2) + 16 * hp + 4 * hi;
            const unsigned h0 = kb == 32 ? k0 : (k0 >> sh), h1 = kb == 32 ? k1 : (k1 >> sh);
            bool sel0 = h0 > prefix, sel1 = h1 > prefix;
            if (kb == 32) {
                if (h0 == prefix) sel0 = lds_add(&sm[32 + q], 1u) < rem;
                if (h1 == prefix) sel1 = lds_add(&sm[32 + q], 1u) < rem;
            } else {
                if (h0 == prefix) { const unsigned sl = lds_add(&sm[64 + q], 1u); if (sl < (unsigned)IX_CAP) cand[sl] = ((unsigned long long)k0 << 16) | (unsigned)(0xffff - (64 * pi + rowbit)); }
                if (h1 == prefix) { const unsigned sl = lds_add(&sm[64 + q], 1u); if (sl < (unsigned)IX_CAP) cand[sl] = ((unsigned long long)k1 << 16) | (unsigned)(0xffff - (64 * pi + 32 + rowbit)); }
            }
            bits0 |= sel0 ? (1u << rowbit) : 0u; bits1 |= sel1 ? (1u << rowbit) : 0u;
        }
        lds_or(&mst[2 * pi], bits0); lds_or(&mst[2 * pi + 1], bits1);
#pragma unroll
        for (int j = 0; j < 4; ++j) { c0[j] = c1[j]; c1[j] = c2[j]; }
    }
}
__device__ __forceinline__ void ix_select(const int NBITS, LAS unsigned char* lds, int w, int lane) {
    const int WPL = (1 << NBITS) / 128;
    LAS unsigned* sm = (LAS unsigned*)(lds + IX_SM);
#pragma unroll 1
    for (int qq = 0; qq < 2; ++qq) {
        const int q = 2 * w + qq;
        LAS unsigned* hist = (LAS unsigned*)(lds + IX_HIST) + q * IX_HS + lane * WPL;
        unsigned ls = 0;
#pragma unroll 1
        for (int i = 0; i < WPL; ++i) { const unsigned v = hist[i]; ls += (v & 0xffffu) + (v >> 16); }
        unsigned suf = ls;
#pragma unroll
        for (int off = 1; off < 64; off <<= 1) { const unsigned v = __shfl_down(suf, off); if (lane + off < 64) suf += v; }
        const unsigned rem = sm[16 + q]; const unsigned above = suf - ls;
        if (above < rem && rem <= suf) {
            unsigned c = above; int d = 0; unsigned nrem = rem, nbin = 0;
            bool found = false;
#pragma unroll 1
            for (int i = WPL - 1; i >= 0 && !found; --i) {
                const unsigned v = hist[i]; const unsigned chi = v >> 16, clo = v & 0xffffu;
                if (c + chi >= rem) { d = (lane * WPL + i) * 2 + 1; nrem = rem - c; nbin = chi; found = true; }
                else { c += chi; if (c + clo >= rem) { d = (lane * WPL + i) * 2; nrem = rem - c; nbin = clo; found = true; } else c += clo; }
            }
            sm[q] = (sm[q] << NBITS) | (unsigned)d; sm[16 + q] = nrem; sm[48 + q] = nbin;
        }
    }
}
__device__ __forceinline__ void ix_unit(const Params& P, LAS unsigned char* lds, bool isS, int idx, u32x4* kscr) {
    int tid_ = threadIdx.x; asm volatile("" : "+v"(tid_));
    const int tid = tid_, w = __builtin_amdgcn_readfirstlane(tid >> 6), lane = tid & 63;
    int m0, n32, nwords, mstride; const bf16_t* KI; unsigned* MK;
    if (!isS) { m0 = idx * 16; n32 = 2 * ((idx >> 2) + 1); nwords = 8 * ((idx >> 4) + 1); mstride = 512; KI = (const bf16_t*)(P.ws + WS_KIP); MK = (unsigned*)(P.ws + WS_MASKP) + (size_t)m0 * 512; }
    else { const int b = idx >> 2; m0 = SEQ + idx * 16; n32 = 34; nwords = 36; mstride = 36; KI = (const bf16_t*)(P.ws + WS_KIS) + (size_t)b * LS * 64; MK = (unsigned*)(P.ws + WS_MASKS) + (size_t)(idx * 16) * 36; }
    if (n32 <= 8) {
        for (int i = tid; i < 16 * nwords; i += NTHREADS) { const int q = i / nwords, wd = i % nwords; MK[(size_t)q * mstride + wd] = wd < n32 ? 0xffffffffu : 0u; }
        return;
    }
    __syncthreads();
    {
        const bf16_t* QI = (const bf16_t*)(P.ws + WS_QI) + (size_t)m0 * 1024;
#pragma unroll
        for (int i = 0; i < 4; ++i) {
            const int cid = tid + 512 * i, q = cid >> 7, hc = cid & 127, h = hc >> 3, ch = hc & 7;
            *(LAS u32x4*)(lds + (h * 16 + q) * IX_QROW + ch * 16) = *(const u32x4*)(QI + (size_t)q * 1024 + h * 64 + ch * 8);
        }
    }
    u32x4* kc = kscr;
    float wv[8];
    {
        const float* WI = (const float*)(P.ws + WS_WI) + (size_t)(m0 + (lane & 15)) * 16 + ((lane >> 4) & 1);
#pragma unroll
        for (int hh = 0; hh < 8; ++hh) wv[hh] = WI[2 * hh];
    }
    LAS unsigned* sm = (LAS unsigned*)(lds + IX_SM);
    if (tid < 16) { sm[tid] = 0u; sm[16 + tid] = 256u; sm[32 + tid] = 0u; sm[48 + tid] = 0u; sm[64 + tid] = 0u; }
    int kb = 0;
#pragma unroll 1
    for (int level = 0; level < 3; ++level) {
        for (int i = tid; i < 16 * IX_HS / 4; i += NTHREADS) *(LAS u32x4*)(lds + IX_HIST + (size_t)i * 16) = u32x4{0u, 0u, 0u, 0u};
        __syncthreads();
        if (level == 0) ix_pass<0>(0, lds, KI, n32, wv, w, lane, kc); else if (level == 1) ix_pass<1>(0, lds, KI, n32, wv, w, lane); else ix_pass<2>(0, lds, KI, n32, wv, w, lane);
        __syncthreads();
        ix_select(level == 2 ? 10 : 11, lds, w, lane);
        kb += level == 2 ? 10 : 11;
        __syncthreads();
        if (!__any(sm[48 + (lane & 15)] > (unsigned)IX_CAP)) break;
    }
    for (int i = tid; i < 16 * IX_MS / 4; i += NTHREADS) *(LAS u32x4*)(lds + IX_MASK + (size_t)i * 16) = u32x4{0u, 0u, 0u, 0u};
    __syncthreads();
    if (kc) { ix_pass_cached(kb, lds, n32, w, lane, kc); if (n32 > IX_SCR_N32) ix_pass<3>(kb, lds, KI, n32, wv, w, lane, nullptr, IX_SCR_N32 / 2); }
    else ix_pass<3>(kb, lds, KI, n32, wv, w, lane);
    __syncthreads();
#ifdef PROBE_PF
    for (int i = tid; i < 16 * IX_MS / 4; i += NTHREADS) *(LAS u32x4*)(lds + IX_MASK + (size_t)i * 16) = u32x4{0u, 0u, 0u, 0u};
    if (tid < 16) { sm[32 + tid] = 0u; sm[64 + tid] = 0u; }
    __syncthreads();
    ix_pass<3>(kb, lds, KI, n32, wv, w, lane);
    __syncthreads();
#endif
    if (kb < 32) {
#pragma unroll 1
        for (int qq = 0; qq < 2; ++qq) {
            const int q = 2 * w + qq;
            const LAS unsigned long long* cand = (const LAS unsigned long long*)(lds + IX_HIST) + q * IX_CAP;
            LAS unsigned* mst = (LAS unsigned*)(lds + IX_MASK) + q * IX_MS;
            const int n = (int)min(sm[64 + q], (unsigned)IX_CAP); const unsigned rem = sm[16 + q];
            const int nk = (n + 63) >> 6;
            unsigned long long own[8]; unsigned cnt[8];
#pragma unroll
            for (int k = 0; k < 8; ++k) { const int i = lane + 64 * k; own[k] = i < n ? cand[i] : ~0ull; cnt[k] = 0u; }
#pragma unroll 4
            for (int j = 0; j < n; j += 2) {
                typedef unsigned long long u64x2 __attribute__((ext_vector_type(2)));
                const u64x2 x = *(const LAS u64x2*)(cand + j);
                const unsigned long long x0 = x[0], x1 = j + 1 < n ? x[1] : 0ull;
#pragma unroll
                for (int k = 0; k < 8; ++k) if (k < nk) cnt[k] += (x0 > own[k] ? 1u : 0u) + (x1 > own[k] ? 1u : 0u);
            }
#pragma unroll
            for (int k = 0; k < 8; ++k) if (lane + 64 * k < n && cnt[k] < rem) { const unsigned kx = 0xffffu - (unsigned)(own[k] & 0xffffu); lds_or(&mst[kx >> 5], 1u << (kx & 31)); }
        }
    }
    __syncthreads();
    for (int i = tid; i < 16 * nwords; i += NTHREADS) { const int q = i / nwords, wd = i % nwords; MK[(size_t)q * mstride + wd] = ((const LAS unsigned*)(lds + IX_MASK))[q * IX_MS + wd]; }
}
#ifndef IX_NS_SCAN
#define IX_NS_SCAN 0
#endif
__device__ __forceinline__ void indexer_phase(const Params& P, LAS unsigned char* lds) {
    const bool shared = gridDim.x > 32;
    const int G = shared ? (int)gridDim.x - 16 : (int)gridDim.x, bx = shared ? (int)blockIdx.x - 16 : (int)blockIdx.x;
    if (bx < 0) {
        if (shared) for (int i = (int)blockIdx.x; i < IX_NS_SCAN; i += 16) ix_unit(P, lds, true, i, nullptr);
        return;
    }
    const int ns0 = shared ? IX_NS_SCAN : 0;
    u32x4* kscr = (P.ph_hi && shared && G == 240) ? (u32x4*)(P.ws + (bx < (int)IX_SCR_NA ? IX_SCR_A + (size_t)bx * IX_SCR : IX_SCR_B + (size_t)(bx - (int)IX_SCR_NA) * IX_SCR)) : nullptr;
    const int rp = (1024 + G - 1) / G, rs = (128 + G - 1) / G;
#pragma unroll 1
    for (int r = 0; r < rp + rs; ++r) {
        bool isS; int idx;
        if (r < rp) { const int qt = ((r & 1) || r == rp - 1) ? r * G + (G - 1 - bx) : r * G + bx; if (qt >= 1024) continue; isS = false; idx = 1023 - qt; }
        else { const int i = ns0 + (r - rp) * G + bx; if (i >= 128) continue; isS = true; idx = i; }
        ix_unit(P, lds, isS, idx, kscr);
    }
}
namespace att {
constexpr int D = 128, QBLK = 32, KVBLK = 64;
constexpr float SCALE = 0.088388347648318440f;
constexpr float THR = 8.f;
constexpr size_t SHM_V = KVBLK * D * 2, SHM_K = KVBLK * D * 2, SHM_ATTN = 2 * SHM_V + 2 * SHM_K + 8 * 64 * 4;
constexpr int QL_OFF = (int)SHM_ATTN, LUT_OFF = QL_OFF + 8 * 32 * 256;
using f32x8 = __attribute__((ext_vector_type(8))) float;
#define KSWZ(row, colB) ((row) * 256 + ((colB) ^ (((row) & 7) << 4)))
#define SBAR() __builtin_amdgcn_sched_barrier(0)
template <typename TIn> struct Stage;
template <> struct Stage<bf16_t> { using T = bf16x8;
  __device__ static __forceinline__ T ld8(const bf16_t* p) { return *reinterpret_cast<const bf16x8*>(p); }
  __device__ static __forceinline__ bf16x8 tobf(T x) { return x; } };
template <> struct Stage<float> { using T = f32x8;
  __device__ static __forceinline__ T ld8(const float* p) { return *reinterpret_cast<const f32x8*>(p); }
  __device__ static __forceinline__ bf16x8 tobf(T x) {
    u32x4 w = {cvt_pk_bf16(x[0], x[1]), cvt_pk_bf16(x[2], x[3]), cvt_pk_bf16(x[4], x[5]), cvt_pk_bf16(x[6], x[7])}; return *reinterpret_cast<bf16x8*>(&w); } };

__device__ __forceinline__ void partialSM(f32x16& p0, f32x16& p1, float& m_reg, float& mn, float& alpha, const float bC) {
  constexpr float C = SCALE * 1.4426950408889634f;
  float pmax = p0[0]; for (int r = 1; r < 16; ++r) pmax = fmaxf(pmax, p0[r]); for (int r = 0; r < 16; ++r) pmax = fmaxf(pmax, p1[r]);
  { auto rr = __builtin_amdgcn_permlane32_swap(__float_as_uint(pmax), __float_as_uint(pmax), false, false);
    pmax = fmaxf(__uint_as_float(rr[0]), __uint_as_float(rr[1])); }
  if (__builtin_expect(__all(pmax - m_reg <= THR / SCALE), 1)) { mn = m_reg; alpha = 1.f; }
  else { mn = fmaxf(m_reg, pmax); alpha = __builtin_amdgcn_exp2f((m_reg - mn) * C); m_reg = mn; }
  float mnC = -mn * C + bC;
  for (int r = 0; r < 16; ++r) p0[r] = fmaf(p0[r], C, mnC); for (int r = 0; r < 16; ++r) p1[r] = fmaf(p1[r], C, mnC);
  for (int r = 0; r < 16; ++r) p0[r] = __builtin_amdgcn_exp2f(p0[r]);
}
__device__ __forceinline__ void finishSM(f32x16& p0, f32x16& p1, float alpha, float& l_reg, bf16x8& pa0, bf16x8& pa1, bf16x8& pa2, bf16x8& pa3) {
  for (int r = 0; r < 16; ++r) p1[r] = __builtin_amdgcn_exp2f(p1[r]);
  float ps = 0; for (int r = 0; r < 16; ++r) ps += p0[r]; for (int r = 0; r < 16; ++r) ps += p1[r];
  { auto rr = __builtin_amdgcn_permlane32_swap(__float_as_uint(ps), __float_as_uint(ps), false, false);
    ps = __uint_as_float(rr[0]) + __uint_as_float(rr[1]); }
  l_reg = l_reg * alpha + ps;
#define PK4(P, BASE, OUT) do { unsigned a0 = cvt_pk_bf16(P[BASE + 0], P[BASE + 1]), a1 = cvt_pk_bf16(P[BASE + 2], P[BASE + 3]);   \
    unsigned b0 = cvt_pk_bf16(P[BASE + 4], P[BASE + 5]), b1 = cvt_pk_bf16(P[BASE + 6], P[BASE + 7]);                              \
    auto r0 = __builtin_amdgcn_permlane32_swap(a0, b0, false, false); auto r1 = __builtin_amdgcn_permlane32_swap(a1, b1, false, false); \
    u32x4 w = {r0[0], r1[0], r0[1], r1[1]}; OUT = *reinterpret_cast<bf16x8*>(&w); } while (0)
  PK4(p0, 0, pa0); PK4(p0, 8, pa1); PK4(p1, 0, pa2); PK4(p1, 8, pa3);
#undef PK4
}
__device__ __forceinline__ void qkt(f32x16& p0, f32x16& p1, const LAS char* Ks, const LAS char* Qs, int r32, int hi) {
  p0 = f32x16{}; p1 = f32x16{};
  for (int d0 = 0; d0 < 8; ++d0) { int cb = (d0 * 16 + hi * 8) * 2;
    bf16x8 b0 = *reinterpret_cast<const LAS bf16x8*>(Ks + KSWZ(r32, cb));
    bf16x8 b1 = *reinterpret_cast<const LAS bf16x8*>(Ks + KSWZ(32 + r32, cb));
    bf16x8 qf = *reinterpret_cast<const LAS bf16x8*>(Qs + KSWZ(r32, cb));
    p0 = __builtin_amdgcn_mfma_f32_32x32x16_bf16(b0, qf, p0, 0, 0, 0);
    p1 = __builtin_amdgcn_mfma_f32_32x32x16_bf16(b1, qf, p1, 0, 0, 0); }
}
__device__ __forceinline__ int v_st(int k, int c) { const int kk = (k & ~0xC) | ((k & 4) << 1) | ((k & 8) >> 1); return ((kk >> 3) * 4 + (c >> 5)) * 512 + ((kk & 7) * 32 + (c & 31)) * 2; }
__device__ __forceinline__ int v_rd_base(int lane) { return ((lane & 3) << 3) | (((lane >> 2) & 3) << 6) | (((lane >> 4) & 1) << 5) | (((lane >> 5) & 1) << 8); }
constexpr int v_rd_off(int d0, int ks, int half) { return d0 * 512 + ks * 4096 + half * 2048; }
template <int OFF> __device__ __forceinline__ s16x4 tr_read(int vb) {
  s16x4 r; asm volatile("ds_read_b64_tr_b16 %0, %1 offset:%2" : "=&v"(r) : "v"(vb), "i"(OFF) : "memory"); return r;
}
template <int D0> __device__ __forceinline__ void pv_one(f32x16& od, int vb, bf16x8 pa0, bf16x8 pa1, bf16x8 pa2, bf16x8 pa3) {
  const s16x4 l0 = tr_read<v_rd_off(D0, 0, 0)>(vb), h0 = tr_read<v_rd_off(D0, 0, 1)>(vb), l1 = tr_read<v_rd_off(D0, 1, 0)>(vb), h1 = tr_read<v_rd_off(D0, 1, 1)>(vb);
  const s16x4 l2 = tr_read<v_rd_off(D0, 2, 0)>(vb), h2 = tr_read<v_rd_off(D0, 2, 1)>(vb), l3 = tr_read<v_rd_off(D0, 3, 0)>(vb), h3 = tr_read<v_rd_off(D0, 3, 1)>(vb);
  asm volatile("s_waitcnt lgkmcnt(0)" ::: "memory"); SBAR();
#define PK(L, H) (bf16x8){L[0], L[1], L[2], L[3], H[0], H[1], H[2], H[3]}
  od = __builtin_amdgcn_mfma_f32_32x32x16_bf16(pa0, PK(l0, h0), od, 0, 0, 0);
  od = __builtin_amdgcn_mfma_f32_32x32x16_bf16(pa1, PK(l1, h1), od, 0, 0, 0);
  od = __builtin_amdgcn_mfma_f32_32x32x16_bf16(pa2, PK(l2, h2), od, 0, 0, 0);
  od = __builtin_amdgcn_mfma_f32_32x32x16_bf16(pa3, PK(l3, h3), od, 0, 0, 0);
#undef PK
}
__device__ __forceinline__ void pv_d0(f32x16* o, int vb, bf16x8 pa0, bf16x8 pa1, bf16x8 pa2, bf16x8 pa3) {
  pv_one<0>(o[0], vb, pa0, pa1, pa2, pa3); pv_one<1>(o[1], vb, pa0, pa1, pa2, pa3); pv_one<2>(o[2], vb, pa0, pa1, pa2, pa3); pv_one<3>(o[3], vb, pa0, pa1, pa2, pa3);
}
__device__ __forceinline__ void mask_bias(f32x16& p0, f32x16& p1, unsigned long long mw, int hi, bool far, float cfar, const LAS float* lut, int relb) {
  const unsigned lo = (unsigned)mw >> (4 * hi), hw = (unsigned)(mw >> 32) >> (4 * hi);
  const float ninf = -__builtin_inff();
  if (far) {
#pragma unroll
    for (int r = 0; r < 16; ++r) { const int bit = (r & 3) + 8 * (r >> 2);
      const unsigned m0 = (unsigned)__builtin_amdgcn_sbfe((int)lo, bit, 1), m1 = (unsigned)__builtin_amdgcn_sbfe((int)hw, bit, 1);
      p0[r] = __uint_as_float((__float_as_uint(p0[r]) & m0) | (0xff800000u & ~m0)); p1[r] = __uint_as_float((__float_as_uint(p1[r]) & m1) | (0xff800000u & ~m1)); }
  } else {
    const int rb = relb + 4 * hi;
#pragma unroll
    for (int r = 0; r < 16; ++r) { const int bit = (r & 3) + 8 * (r >> 2);
      const int i0 = min(max(rb + bit, 0), 191), i1 = min(max(rb + 32 + bit, 0), 191);
      p0[r] = ((lo >> bit) & 1u) ? p0[r] + lut[i0] : ninf; p1[r] = ((hw >> bit) & 1u) ? p1[r] + lut[i1] : ninf;
      asm volatile("" : "+v"(p0[r]), "+v"(p1[r])); }
  }
}
struct KVSrc { const void* k0; const void* v0; const void* k1; const void* v1; int splitT; };

template <typename TKV, int SDEPTH>
__device__ __forceinline__ void attn_unit(const bf16_t* __restrict__ Qb, const KVSrc kv, bf16_t* __restrict__ Ob, int NT, const unsigned long long* __restrict__ maskb, int mstride,
                                          int qpos0, int nvalid, int jlbase, LAS char* lds, const int tid) {
  using St = Stage<TKV>;
  const int wid = __builtin_amdgcn_readfirstlane(tid >> 6), lane = tid & 63, r32 = lane & 31, hi = lane >> 5;
  LAS char* V_lds = lds; LAS char* K_lds = lds + 2 * SHM_V;
  LAS float* wsl = (LAS float*)(lds + 2 * SHM_V + 2 * SHM_K) + wid * 64; LAS float* li_l = wsl; LAS float* al_l = wsl + 32;
  const LAS float* lut = (const LAS float*)(lds + LUT_OFF);
  float m_reg = -1e30f, l_reg = 0; f32x16 o[4] = {};
  LAS char* qr = lds + QL_OFF + wid * 8192;
  const int wrow = (wid * QBLK < nvalid) ? wid * QBLK : (wid * QBLK) % nvalid;
  const bool wvalid = wid * QBLK < nvalid;
  const int jl = wvalid ? (jlbase < 0 ? -jlbase : jlbase + (wid >> 1) + 1) : 0;
  const bf16_t* Qw = Qb + (size_t)(wrow + r32) * DM + hi * 8;
#pragma unroll
  for (int d0 = 0; d0 < 8; ++d0) *reinterpret_cast<LAS bf16x8*>(qr + KSWZ(r32, (d0 * 16 + hi * 8) * 2)) = *reinterpret_cast<const bf16x8*>(Qw + d0 * 16);
  const unsigned moff = (unsigned)((wrow + r32) * mstride);
  const int qpos = qpos0 + wrow + r32, qposw = qpos0 + wrow;
  const float cfar = lut[0]; const float cfarC = cfar * (SCALE * 1.4426950408889634f); float bC_ = 0.f;
  const int sr = tid >> 4, sc = (tid & 15) * 8, vst0 = v_st(sr, sc), vst1 = v_st(32 + sr, sc);
  const int vb0 = (int)(uintptr_t)V_lds + v_rd_base(lane);
  const int lofs = sr * DM + sc;
  struct { typename St::T vs0, vs1, ks0, ks1; } sr_[SDEPTH];
#define SLOAD(i, k0_) do { const int jt_ = (k0_) >> 6; const bool fst_ = jt_ < kv.splitT; \
    const TKV* kb_ = (fst_ ? (const TKV*)kv.k0 + (size_t)jt_ * 64 * DM : (const TKV*)kv.k1) + lofs; const TKV* vb_ = (fst_ ? (const TKV*)kv.v0 + (size_t)jt_ * 64 * DM : (const TKV*)kv.v1) + lofs; \
    sr_[i].vs0 = St::ld8(vb_); sr_[i].vs1 = St::ld8(vb_ + 32 * DM); sr_[i].ks0 = St::ld8(kb_); sr_[i].ks1 = St::ld8(kb_ + 32 * DM); } while (0)
#define SWRITE(b, i) do { *(LAS bf16x8*)(V_lds + (b) * SHM_V + vst0) = St::tobf(sr_[i].vs0);          \
    *(LAS bf16x8*)(V_lds + (b) * SHM_V + vst1) = St::tobf(sr_[i].vs1); int kc = sc * 2;               \
    *(LAS bf16x8*)(K_lds + (b) * SHM_K + KSWZ(sr, kc)) = St::tobf(sr_[i].ks0);                       \
    *(LAS bf16x8*)(K_lds + (b) * SHM_K + KSWZ(32 + sr, kc)) = St::tobf(sr_[i].ks1); } while (0)
#define SWAIT() do { if constexpr (SDEPTH == 2) asm volatile("s_waitcnt vmcnt(4)" ::: "memory"); else asm volatile("s_waitcnt vmcnt(0)" ::: "memory"); } while (0)
#define RESC(a) do { if (__any((a) < 1.f)) { if (hi == 0) al_l[r32] = (a); asm volatile("s_waitcnt lgkmcnt(0)" ::: "memory"); \
    for (int d = 0; d < 4; ++d) for (int r = 0; r < 16; ++r) o[d][r] *= al_l[crow(r, hi)]; } } while (0)
#define MB(P0, P1, j) do { const unsigned long long mw_ = mwn; if ((j) + 1 < NT) mwn = maskb[moff + (unsigned)((j) + 1)];     \
    const bool far_ = 64 * (j) + 191 <= qposw; bC_ = far_ ? cfarC : 0.f; mask_bias(P0, P1, mw_, hi, far_, cfar, lut, 64 * (j) - qpos + 128); } while (0)
  f32x16 pA0, pA1, pB0, pB1; float mnA, mnB, alA, alB; bf16x8 pa0, pa1, pa2, pa3;
  unsigned long long mwn = maskb[moff];
  constexpr int SE = 0, SO = SDEPTH - 1;
  SLOAD(SE, 0); asm volatile("s_waitcnt vmcnt(0)" ::: "memory"); SWRITE(0, SE); __syncthreads();
  if (0 < jl) { qkt(pA0, pA1, K_lds, qr, r32, hi); MB(pA0, pA1, 0); partialSM(pA0, pA1, m_reg, mnA, alA, bC_); }
  SLOAD(SO, KVBLK); if constexpr (SDEPTH == 2) { if (2 < NT) SLOAD(SE, 2 * KVBLK); }
  SWAIT(); SWRITE(1, SO); __syncthreads();
  for (int j = 1; j + 1 < NT; j += 2) {
    SBAR(); if (j < jl) { qkt(pB0, pB1, K_lds + SHM_K, qr, r32, hi); MB(pB0, pB1, j); }
    if (j - 1 < jl) finishSM(pA0, pA1, alA, l_reg, pa0, pa1, pa2, pa3); SBAR();
    SLOAD(SO, (j + SDEPTH) * KVBLK); SBAR();
    if (j - 1 < jl) pv_d0(o, vb0, pa0, pa1, pa2, pa3); if (j < jl) partialSM(pB0, pB1, m_reg, mnB, alB, bC_);
    __syncthreads(); SWAIT(); SWRITE(0, SE);
    if (j < jl) RESC(alB); __syncthreads();
    SBAR(); if (j + 1 < jl) { qkt(pA0, pA1, K_lds, qr, r32, hi); MB(pA0, pA1, j + 1); }
    if (j < jl) finishSM(pB0, pB1, alB, l_reg, pa0, pa1, pa2, pa3); SBAR();
    if (SDEPTH == 1 || j + 3 < NT) SLOAD(SE, (j + 1 + SDEPTH) * KVBLK); SBAR();
    if (j < jl) pv_d0(o, vb0 + (int)SHM_V, pa0, pa1, pa2, pa3); if (j + 1 < jl) partialSM(pA0, pA1, m_reg, mnA, alA, bC_);
    __syncthreads(); SWAIT(); SWRITE(1, SO);
    if (j + 1 < jl) RESC(alA); __syncthreads();
  }
  SBAR(); if (NT - 1 < jl) { qkt(pB0, pB1, K_lds + SHM_K, qr, r32, hi); MB(pB0, pB1, NT - 1); }
  if (NT - 2 < jl) finishSM(pA0, pA1, alA, l_reg, pa0, pa1, pa2, pa3); SBAR();
  if (NT - 2 < jl) pv_d0(o, vb0, pa0, pa1, pa2, pa3); if (NT - 1 < jl) partialSM(pB0, pB1, m_reg, mnB, alB, bC_);
  __syncthreads();
  if (NT - 1 < jl) { RESC(alB); finishSM(pB0, pB1, alB, l_reg, pa0, pa1, pa2, pa3); SBAR();
    pv_d0(o, vb0 + (int)SHM_V, pa0, pa1, pa2, pa3); }
  if (hi == 0) li_l[r32] = l_reg; asm volatile("s_waitcnt lgkmcnt(0)" ::: "memory");
  float rli[16];
#pragma unroll
  for (int r = 0; r < 16; ++r) rli[r] = __builtin_amdgcn_rcpf(li_l[crow(r, hi)]);
  if (wvalid) {
    int lo_ = lane; asm volatile("" : "+v"(lo_));
    const int r32o = lo_ & 31, hio = lo_ >> 5;
    LAS char* ot = qr;
#pragma unroll
    for (int r = 0; r < 16; ++r) { const int orow = crow(r, hio);
#pragma unroll
      for (int d0 = 0; d0 < 4; ++d0) { const int dv = d0 * 32 + r32o;
        *(LAS bf16_t*)(ot + orow * 256 + ((((dv >> 3) ^ (orow & 7)) << 4) | ((dv & 7) << 1))) = f2bf(o[d0][r] * rli[r]); } }
    asm volatile("" ::: "memory");
    const int ch = lo_ & 15, rq = lo_ >> 4;
    bf16_t* Ow = Ob + (size_t)(wid * QBLK) * DM + ch * 8;
#pragma unroll
    for (int it = 0; it < 8; ++it) { const int row = it * 4 + rq;
      const u32x4 v = *(const LAS u32x4*)(ot + row * 256 + ((ch ^ (row & 7)) << 4));
      *(u32x4*)(Ow + (size_t)row * DM) = v; }
  }
  __syncthreads();
#undef SLOAD
#undef SWRITE
#undef SWAIT
#undef RESC
#undef MB
}
#undef KSWZ
#undef SBAR
}

__device__ __forceinline__ int t5_bucket(int rel) {
    const int n = rel < 0 ? -rel : rel;
    const int lg = n < 8 ? n : (n < 12 ? 8 : (n < 16 ? 9 : (n < 23 ? 10 : (n < 32 ? 11 : (n < 46 ? 12 : (n < 64 ? 13 : (n < 91 ? 14 : 15)))))));
    return (rel > 0 ? 16 : 0) + lg;
}
__device__ __forceinline__ void attn_phase(const Params& P, LAS unsigned char* lds) {
    const int G = gridDim.x, bx = blockIdx.x;
    bf16_t* Q = (bf16_t*)(P.ws + WS_Q); bf16_t* O = (bf16_t*)(P.ws + WS_H);
    LAS float* lut = (LAS float*)(lds + att::LUT_OFF);
#pragma unroll 1
    for (int r = 0; r * G < 1024; ++r) {
        const int t = (r & 1) ? r * G + (G - 1 - bx) : r * G + bx; if (t >= 1024) continue;
        const int idx = 1023 - t, h = idx & 15, blk = idx >> 4;
        int tid = threadIdx.x; asm volatile("" : "+v"(tid));
        __syncthreads();
        if (tid < 192) lut[tid] = P.in[10][t5_bucket(tid - 128) * 16 + h] * (1.0f / att::SCALE);
        __syncthreads();
        att::KVSrc kv{(const bf16_t*)(P.ws + WS_KP) + h * 128, (const bf16_t*)(P.ws + WS_VP) + h * 128, nullptr, nullptr, 1 << 30};
        att::attn_unit<bf16_t, 1>(Q + (size_t)(256 * blk) * DM + h * 128, kv, O + (size_t)(256 * blk) * DM + h * 128, 4 * (blk + 1),
                                  (const unsigned long long*)(P.ws + WS_MASKP) + (size_t)(256 * blk) * 256, 256, 256 * blk, 256, 4 * blk, (LAS char*)lds, tid);
    }
#pragma unroll 1
    for (int i = bx; i < 512; i += G) {
        const int h = i & 15, blk = i >> 4;
        int tid = threadIdx.x; asm volatile("" : "+v"(tid));
        __syncthreads();
        if (tid < 192) lut[tid] = P.in[10][t5_bucket(tid - 128) * 16 + h] * (1.0f / att::SCALE);
        __syncthreads();
        att::KVSrc kv{P.in[4] + (size_t)blk * PAST * DM + h * 128, P.in[5] + (size_t)blk * PAST * DM + h * 128,
                      P.out + O_KS + (size_t)blk * TS * DM + h * 128, P.out + O_VS + (size_t)blk * TS * DM + h * 128, PAST / 64};
        att::attn_unit<float, 1>(Q + (size_t)(SEQ + 64 * blk) * DM + h * 128, kv, O + (size_t)(SEQ + 64 * blk) * DM + h * 128, 18,
                                 (const unsigned long long*)(P.ws + WS_MASKS) + (size_t)(64 * blk) * 18, 18, PAST, 64, -17, (LAS char*)lds, tid);
    }
}
#ifdef PROBE_ATT
constexpr int PR_NCHK = 96;
#ifndef PROBE_SHIFT
#define PROBE_SHIFT 0
#endif
__device__ __forceinline__ int probe_row(int i) { return i < 80 ? (i < 78 ? 200 + 207 * i : (i == 78 ? SEQ - 1 : SEQ - 70)) : SEQ + (i == 80 ? 0 : (i == 81 ? 63 : (i == 82 ? 2047 : 131 * (i - 82)))); }
__device__ __forceinline__ void probe_phase(const Params& P, LAS unsigned char* lds) {
    const int tid = threadIdx.x, lane = tid & 63;
    LAS float* qf = (LAS float*)lds;
    LAS float* red = (LAS float*)(lds + 8192);
    LAS int* sel = (LAS int*)(lds + 16384);
    LAS float* lg = (LAS float*)(lds + 20480);
    LAS float* qv = (LAS float*)(lds + 40960);
    unsigned* errw = (unsigned*)(P.ws + WS_CTL + 32768);
    float* scr = (float*)(P.ws + WS_WIN);
    for (int it = blockIdx.x; it < PR_NCHK; it += gridDim.x) {
        const int m = probe_row(it); const bool isP = m < SEQ; const int b = (m - SEQ) >> 6, t = (m - SEQ) & 63;
        const int n = isP ? 64 * (m / 64 + 1) : LS; const int qpos = isP ? m : PAST + t;
        const bf16_t* KI = isP ? (const bf16_t*)(P.ws + WS_KIP) : (const bf16_t*)(P.ws + WS_KIS) + (size_t)b * LS * 64;
        const unsigned* MK = isP ? (const unsigned*)(P.ws + WS_MASKP) + (size_t)m * 512 : (const unsigned*)(P.ws + WS_MASKS) + (size_t)(m - SEQ) * 36;
        float* sc = scr + (size_t)blockIdx.x * 16384;
        __syncthreads();
        for (int i = tid; i < 1024; i += NTHREADS) qf[i] = bf2f(((const bf16_t*)(P.ws + WS_QI))[(size_t)m * 1024 + i]);
        for (int i = tid; i < 2048; i += NTHREADS) qv[i] = bf2f(((const bf16_t*)(P.ws + WS_Q))[(size_t)m * DM + i]);
        __syncthreads();
        const float* WI = (const float*)(P.ws + WS_WI) + (size_t)m * 16;
        for (int k = tid; k < n; k += NTHREADS) {
            float s = 0.f;
            for (int h = 0; h < 16; ++h) { float d = 0.f; for (int e = 0; e < 64; ++e) d = fmaf(qf[h * 64 + e], bf2f(KI[(size_t)k * 64 + e]), d); s = fmaf(fmaxf(d, 0.f), WI[h], s); }
            sc[k] = s;
        }
        __syncthreads();
        int pop = 0; float mnsel = 3e38f, mxuns = -3e38f, amax = 0.f;
        for (int k = tid; k < n; k += NTHREADS) { const bool s = (MK[k >> 5] >> (k & 31)) & 1u; const float v = sc[k]; pop += s ? 1 : 0; if (s) mnsel = fminf(mnsel, v); else mxuns = fmaxf(mxuns, v); amax = fmaxf(amax, fabsf(v)); }
        for (int off = 32; off; off >>= 1) { pop += __shfl_xor(pop, off); mnsel = fminf(mnsel, __shfl_xor(mnsel, off)); mxuns = fmaxf(mxuns, __shfl_xor(mxuns, off)); amax = fmaxf(amax, __shfl_xor(amax, off)); }
        if (lane == 0) { red[(tid >> 6) * 4 + 0] = (float)pop; red[(tid >> 6) * 4 + 1] = mnsel; red[(tid >> 6) * 4 + 2] = mxuns; red[(tid >> 6) * 4 + 3] = amax; }
        __syncthreads();
        if (tid == 0) {
            float p = 0.f, a = 3e38f, c = -3e38f, d = 0.f;
            for (int w = 0; w < 8; ++w) { p += red[w * 4]; a = fminf(a, red[w * 4 + 1]); c = fmaxf(c, red[w * 4 + 2]); d = fmaxf(d, red[w * 4 + 3]); }
            const float e1 = fabsf(p - (float)(n < 256 ? n : 256));
            const float e2 = (n > 256 && c > -1e38f) ? fmaxf(c - a, 0.f) / (d + 1e-20f) : 0.f;
            atomicMax(errw + 0, __float_as_uint(e1)); atomicMax(errw + 1, __float_as_uint(e2));
            int cnt = 0;
            for (int k = 0; k < n && cnt < 320; ++k) if ((MK[k >> 5] >> (k & 31)) & 1u) sel[cnt++] = k;
            sel[320] = cnt;
        }
        __syncthreads();
        const int ns = sel[320];
        const int h = tid >> 5, l32 = tid & 31;
        float mx = -3e38f;
        for (int j = l32; j < ns; j += 32) {
            const int k = sel[j]; float d = 0.f;
            for (int e = 0; e < 128; ++e) {
                float kv;
                if (isP) kv = bf2f(((const bf16_t*)(P.ws + WS_KP))[(size_t)k * DM + h * 128 + e]);
                else kv = k < PAST ? P.in[4][((size_t)b * PAST + k) * DM + h * 128 + e] : P.out[O_KS + ((size_t)b * TS + (k - PAST)) * DM + h * 128 + e];
                d = fmaf(qv[h * 128 + e], isP ? kv : bf2f(f2bf(kv)), d);
            }
            const float lgt = d * 0.08838834764831845f + P.in[10][t5_bucket(k - qpos + PROBE_SHIFT) * 16 + h];
            lg[h * 256 + j] = lgt; mx = fmaxf(mx, lgt);
        }
        for (int off = 16; off; off >>= 1) mx = fmaxf(mx, __shfl_xor(mx, off));
        float sum = 0.f;
        for (int j = l32; j < ns; j += 32) { const float p = expf(lg[h * 256 + j] - mx); lg[h * 256 + j] = p; sum += p; }
        for (int off = 16; off; off >>= 1) sum += __shfl_xor(sum, off);
        __syncthreads();
        float o[4] = {0.f, 0.f, 0.f, 0.f};
        for (int j = 0; j < ns; ++j) {
            const int k = sel[j]; const float p = bf2f(f2bf(lg[h * 256 + j]));
#pragma unroll
            for (int c = 0; c < 4; ++c) {
                const int e = l32 * 4 + c; float vv;
                if (isP) vv = bf2f(((const bf16_t*)(P.ws + WS_VP))[(size_t)k * DM + h * 128 + e]);
                else vv = bf2f(f2bf(k < PAST ? P.in[5][((size_t)b * PAST + k) * DM + h * 128 + e] : P.out[O_VS + ((size_t)b * TS + (k - PAST)) * DM + h * 128 + e]));
                o[c] = fmaf(p, vv, o[c]);
            }
        }
        float ss = 0.f, dd = 0.f;
#pragma unroll
        for (int c = 0; c < 4; ++c) { const float r = o[c] / sum; const float f = bf2f(((const bf16_t*)(P.ws + WS_H))[(size_t)m * DM + h * 128 + l32 * 4 + c]); ss += r * r; dd += (r - f) * (r - f); }
        for (int off = 16; off; off >>= 1) { ss += __shfl_xor(ss, off); dd += __shfl_xor(dd, off); }
        if (l32 == 0) atomicMax(errw + 2, __float_as_uint(sqrtf(dd / (ss + 1e-30f))));
    }
}

__device__ __forceinline__ void probe_delta(const Params& P, LAS unsigned char* lds) {
    const int tid = threadIdx.x;
    LAS float* S = (LAS float*)lds;
    LAS float* qv = (LAS float*)(lds + 65536);
    LAS float* kv = qv + 128; LAS float* vv = qv + 256; LAS float* kS = qv + 384; LAS float* sc = qv + 512;
    LAS float* red = qv + 640;
    unsigned* errw = (unsigned*)(P.ws + WS_CTL + 32768);
    const bf16_t* QKVB = (const bf16_t*)(P.ws + WS_QKVB);
    const bf16_t* OBp = (const bf16_t*)(P.ws + WS_OB);
    for (int it = blockIdx.x; it < 64; it += gridDim.x) {
        const int b = (it * 7) & 31, h = it & 15;
        __syncthreads();
        for (int i = tid; i < 16384; i += NTHREADS) S[i] = P.in[8][((size_t)b * 16 + h) * 16384 + i];
        float dd = 0.f, ss = 0.f;
        for (int t = 0; t < 64; ++t) {
            const int m = SEQ + 64 * b + t;
            __syncthreads();
            if (tid < 384) {
                const int which = tid >> 7, c = tid & 127, col = which * 2048 + h * 128 + c;
                float acc = 0.f;
                for (int i = 0; i < 4; ++i) {
                    const int tt = t - 3 + i;
                    const float x = tt >= 0 ? bf2f(QKVB[(size_t)(SEQ + 64 * b + tt) * CONVB + col]) : P.in[7][((size_t)b * 3 + (3 + tt)) * CONVB + col];
                    acc = fmaf(P.in[16][(size_t)i * CONVB + col], x, acc);
                }
                qv[tid] = acc / (1.0f + expf(-acc));
            }
            if (tid == 384) {
                const float ab = ((const float*)(P.ws + WS_AB))[(size_t)m * 16 + h], bb = ((const float*)(P.ws + WS_BB))[(size_t)m * 16 + h];
                const float x = ab + P.in[18][h];
                sc[0] = expf(-expf(P.in[17][h]) * (x > 20.f ? x : log1pf(expf(x)))); sc[1] = 1.0f / (1.0f + expf(-bb));
            }
            __syncthreads();
            if (tid < 128) {
                float sq = 0.f, sk = 0.f; for (int i = 0; i < 128; ++i) { sq += qv[i] * qv[i]; sk += kv[i] * kv[i]; }
                sc[2] = rsqrtf(sq + 1e-6f) * 0.08838834764831845f; sc[3] = rsqrtf(sk + 1e-6f);
            }
            __syncthreads();
            if (tid < 128) { float a = 0.f; for (int i = 0; i < 128; ++i) a = fmaf(kv[i] * sc[3], S[i * 128 + tid], a); kS[tid] = a; }
            __syncthreads();
            { const float eg = sc[0], be = sc[1];
              for (int e = tid; e < 16384; e += NTHREADS) { const int i = e >> 7, j = e & 127; const float ki = kv[i] * sc[3]; S[e] = eg * (S[e] - be * ki * kS[j]) + be * ki * vv[j]; } }
            __syncthreads();
            if (tid < 128) {
                float o = 0.f; for (int i = 0; i < 128; ++i) o = fmaf(S[i * 128 + tid], qv[i] * sc[2], o);
                const float f = bf2f(OBp[(size_t)m * DM + h * 128 + tid]);
                dd += (o - f) * (o - f); ss += o * o;
            }
        }
        for (int off = 32; off; off >>= 1) { dd += __shfl_xor(dd, off); ss += __shfl_xor(ss, off); }
        if ((tid & 63) == 0 && tid < 128) { red[(tid >> 6) * 2] = dd; red[(tid >> 6) * 2 + 1] = ss; }
        __syncthreads();
        if (tid == 0) atomicMax(errw + 3, __float_as_uint(sqrtf((red[0] + red[2]) / (red[1] + red[3] + 1e-30f))));
    }
}
__device__ __forceinline__ void probe_report(const Params& P) {
    const unsigned* errw = (const unsigned*)(P.ws + WS_CTL + 32768);
    const float e = __uint_as_float(errw[PROBE_ATT - 1]);
    const float f = 1.0f + fminf(PROBE_GAIN * e, 1e6f);
    for (int i = blockIdx.x * NTHREADS + threadIdx.x; i < NB * TS * 64; i += gridDim.x * NTHREADS) P.out[O_KIS + i] *= f;
}
#endif
#ifndef MK_MODE
#define MK_MODE 2
#endif
constexpr int NPHASE = 14;
template <int LO, int HI> __global__ void __launch_bounds__(NTHREADS, 2) hybrid_fwd(const Params PK) {
    const Params& P = PK;
    extern __shared__ __attribute__((aligned(16))) unsigned char lds_raw[];
    LAS unsigned char* lds = (LAS unsigned char*)lds_raw;
    volatile LAS unsigned* st = (volatile LAS unsigned*)(lds + MISC_OFF);
    if (threadIdx.x == 0) { st[0] = 0u; st[1] = 0u; st[2] = 0u; st[3] = 0u; }
    __syncthreads();
    if (HI - LO > 1) (void)xcd_barrier_post((unsigned*)(PK.ws + WS_CTL) + PK.ph_lo * XCD_BAR_WORDS, st);
#define IN(k) (LO <= (k) && (k) < HI)
#ifndef MK_DOUBLE
#define MK_DOUBLE -1
#endif
#define PHASE(k) if (IN(k)) for (int rep_ = 0; rep_ < ((k) == MK_DOUBLE ? 2 : 1); ++rep_)
#define SEAM(k) do { if (IN(k) && IN((k) + 1)) { XcdBarrier b_; b_.bar = (unsigned*)(PK.ws + WS_CTL) + PK.ph_lo * XCD_BAR_WORDS; b_.x = xb_xcc_id(); b_.st = (volatile LAS unsigned*)(lds + MISC_OFF); xcd_barrier(b_); } } while (0)
    PHASE(0) {
        adaln_phase(P, lds);
        xpose_phase(P, lds);
        const float* ck = P.in[6]; bf16_t* KIS = (bf16_t*)(P.ws + WS_KIS);
        for (int t = blockIdx.x * NTHREADS + threadIdx.x; t < NB * PAST * 8; t += gridDim.x * NTHREADS) {
            const int b = t >> 13, rem = t & 8191;
            const f32x4 a = *(const f32x4*)(ck + (size_t)t * 8), c = *(const f32x4*)(ck + (size_t)t * 8 + 4);
            u32x4 o; o.x = cvt_pk_bf16(a[0], a[1]); o.y = cvt_pk_bf16(a[2], a[3]); o.z = cvt_pk_bf16(c[0], c[1]); o.w = cvt_pk_bf16(c[2], c[3]);
            *(u32x4*)(KIS + (size_t)b * LS * 64 + (size_t)rem * 8) = o;
        }
    }
    SEAM(0);
    PHASE(1) normmod_phase<0>(P);
    SEAM(1);
    PHASE(2) {
        pg8::Gemm g{(const bf16_t*)(P.ws + WS_H), (const bf16_t*)(P.ws + WS_WIN), MT, NPAD, DM}; pg8::StaticOrder S; S.init(MT, NPAD, (int)gridDim.x, (int)blockIdx.x);
        pg8::EpiIn E{P.out, P.ws};
        pg8::gemm_phase<pg8::EpiIn, pg8::StaticOrder>(lds, g, S, E, nullptr);
        xpose_tail_inproj(P, lds);
    }
    SEAM(2);
    PHASE(3) d1_phase(P, lds);
    SEAM(3);
    PHASE(4) d2_phase(P, lds);
    PHASE(5) indexer_phase(P, lds);
    SEAM(5);
#if defined(PROBE_ATT) && PROBE_ATT == 4
    probe_delta(P, lds);
    { XcdBarrier b_; b_.bar = (unsigned*)(PK.ws + WS_CTL) + PK.ph_lo * XCD_BAR_WORDS; b_.x = xb_xcc_id(); b_.st = (volatile LAS unsigned*)(lds + MISC_OFF); xcd_barrier(b_); }
#endif
    PHASE(6) attn_phase(P, lds);
    SEAM(6);
#if defined(PROBE_ATT) && PROBE_ATT != 4
    probe_phase(P, lds);
    { XcdBarrier b_; b_.bar = (unsigned*)(PK.ws + WS_CTL) + PK.ph_lo * XCD_BAR_WORDS; b_.x = xb_xcc_id(); b_.st = (volatile LAS unsigned*)(lds + MISC_OFF); xcd_barrier(b_); }
#endif
    PHASE(7) merge_phase(P);
    SEAM(7);
    PHASE(8) {
        pg8::Gemm g{(const bf16_t*)(P.ws + WS_H), (const bf16_t*)(P.ws + WS_WOUT), MT, DM, DM}; pg8::SplitOrder S; S.init(MT, DM, (int)gridDim.x, (int)blockIdx.x);
        pg8::EpiRes<0> E{P.in[0], P.in[1], P.out, (const float*)(P.ws + WS_MOD)};
        pg8::gemm_phase<pg8::EpiRes<0>, pg8::SplitOrder>(lds, g, S, E, nullptr);
    }
    SEAM(8);
    PHASE(9) normmod_phase<1>(P);
    SEAM(9);
    PHASE(10) {
        pg8::Gemm g{(const bf16_t*)(P.ws + WS_H), (const bf16_t*)(P.ws + WS_WGU), MT, 2 * DFF, DM}; pg8::StaticOrder S; S.init(MT, 2 * DFF, (int)gridDim.x, (int)blockIdx.x);
        pg8::EpiGU E{P.out, P.ws, P.in[23], P.in[24], P.in[9]};
        pg8::gemm_phase<pg8::EpiGU, pg8::StaticOrder>(lds, g, S, E, nullptr);
        xpose_tail_gateup(P, lds);
    }
    SEAM(10);
    PHASE(11) ffn_seam_phase(P);
    SEAM(11);
    PHASE(12) {
        pg8::Gemm g{(const bf16_t*)(P.ws + WS_UP), (const bf16_t*)(P.ws + WS_WDN), MT, DM, DFF}; pg8::SplitOrder S; S.init(MT, DM, (int)gridDim.x, (int)blockIdx.x);
        pg8::EpiRes<1> E{P.in[0], P.in[1], P.out, (const float*)(P.ws + WS_MOD)};
        pg8::gemm_phase<pg8::EpiRes<1>, pg8::SplitOrder>(lds, g, S, E, nullptr);
    }
    SEAM(12);
    PHASE(13) finalnorm_phase(P);
#ifdef PROBE_ATT
    { XcdBarrier b_; b_.bar = (unsigned*)(PK.ws + WS_CTL) + PK.ph_lo * XCD_BAR_WORDS; b_.x = xb_xcc_id(); b_.st = (volatile LAS unsigned*)(lds + MISC_OFF); xcd_barrier(b_); }
    probe_report(P);
#endif
#undef IN
#undef SEAM
}

extern "C" void kernel_launch(void* const* d_in, const int* in_sizes, int n_in, void* d_out, int out_size, void* d_ws, size_t ws_size, hipStream_t stream) {
    static int grid = 0;
    if (grid == 0) {
        if (n_in != 27 || out_size != (int)O_END || ws_size < WS_END) { fprintf(stderr, "kernel_launch: unexpected shapes (n_in %d, out %d, ws %zu, need %zu)\n", n_in, out_size, ws_size, (size_t)WS_END); grid = -1; return; }
        int dev = 0, cus = 0, per_cu = 0;
        if (hipGetDevice(&dev) != hipSuccess || hipDeviceGetAttribute(&cus, hipDeviceAttributeMultiprocessorCount, dev) != hipSuccess) { grid = -1; return; }
        hipError_t e = hipSuccess;
#define SETLDS(LO_, HI_) do { if (e == hipSuccess) e = hipFuncSetAttribute((const void*)(hybrid_fwd<LO_, HI_>), hipFuncAttributeMaxDynamicSharedMemorySize, LDS_BYTES); } while (0)
#if MK_MODE == 0
        SETLDS(0, 1); SETLDS(1, 2); SETLDS(2, 3); SETLDS(3, 4); SETLDS(4, 5); SETLDS(5, 6); SETLDS(6, 7); SETLDS(7, 8); SETLDS(8, 9); SETLDS(9, 10); SETLDS(10, 11); SETLDS(11, 12); SETLDS(12, 13); SETLDS(13, 14);
        const void* kq = (const void*)(hybrid_fwd<2, 3>);
#elif MK_MODE == 1
        SETLDS(0, 1); SETLDS(1, 14);
        const void* kq = (const void*)(hybrid_fwd<1, 14>);
#else
        SETLDS(0, 14);
        const void* kq = (const void*)(hybrid_fwd<0, 14>);
#endif
        if (e != hipSuccess) { fprintf(stderr, "kernel_launch: hipFuncSetAttribute failed\n"); grid = -1; return; }
        if (hipOccupancyMaxActiveBlocksPerMultiprocessor(&per_cu, kq, NTHREADS, LDS_BYTES) != hipSuccess || per_cu < 1) { fprintf(stderr, "kernel_launch: occupancy query says %d\n", per_cu); (void)hipGetLastError(); per_cu = 1; }
        grid = cus;
    }
    if (grid < 0) return;
    (void)hipMemsetAsync((char*)d_ws + WS_CTL, 0, 65536, stream);
    Params p{};
    for (int i = 0; i < 27; ++i) p.in[i] = (const float*)d_in[i];
    p.out = (float*)d_out; p.ws = (unsigned char*)d_ws;
#define LAUNCH(LO_, HI_, region) do { p.ph_lo = (region); p.ph_hi = (ws_size >= WS_END2) ? 1 : 0;     hipLaunchKernelGGL((hybrid_fwd<LO_, HI_>), dim3(grid), dim3(NTHREADS), LDS_BYTES, stream, p); } while (0)
#if MK_MODE == 0
    LAUNCH(0, 1, 0); LAUNCH(1, 2, 0); LAUNCH(2, 3, 0); LAUNCH(3, 4, 0); LAUNCH(4, 5, 0); LAUNCH(5, 6, 0); LAUNCH(6, 7, 0);
    LAUNCH(7, 8, 0); LAUNCH(8, 9, 0); LAUNCH(9, 10, 0); LAUNCH(10, 11, 0); LAUNCH(11, 12, 0); LAUNCH(12, 13, 0); LAUNCH(13, 14, 0);
#elif MK_MODE == 1
    LAUNCH(0, 1, 0); LAUNCH(1, 14, 1);
#else
    LAUNCH(0, 14, 0);
#endif
    const hipError_t le = hipPeekAtLastError();
    if (le != hipSuccess) fprintf(stderr, "kernel_launch: launch failed: %s\n", hipGetErrorName(le));
}
```

```cpp
#include <hip/hip_runtime.h>
#include <stdint.h>
#include <cstdio>

#define LAS __attribute__((address_space(3)))
typedef unsigned short bf16_t;
typedef short bf16x8 __attribute__((ext_vector_type(8)));
typedef short s16x4 __attribute__((ext_vector_type(4)));
typedef float f32x4 __attribute__((ext_vector_type(4)));
typedef float f32x2 __attribute__((ext_vector_type(2)));
typedef float f32x16 __attribute__((ext_vector_type(16)));
typedef unsigned u32x4 __attribute__((ext_vector_type(4)));
typedef unsigned u32x2 __attribute__((ext_vector_type(2)));

constexpr int DM = 2048, SEQ = 16384, NB = 32, TS = 64, PAST = 1024, LS = PAST + TS;
constexpr int MT = SEQ + NB * TS;
constexpr int NSEQ = 1 + NB;
constexpr int DFF = 5632, CONVB = 6144, DIN = 19568;
constexpr int NPAD = 19712;
constexpr int NUNIT = 288 * 16;
constexpr int UB_W = 0, UB_QG = 16896, UB_A = 33792, UB_KD = 42496, UB_U = 59904, UNITB = 76288, RW = 264, RA = 136;
constexpr size_t O_YP = 0, O_YS = 33554432, O_KP = 37748736, O_VP = 71303168, O_KIP = 104857600, O_CBP = 105906176, O_DP = 105924608, O_FP = 106186752,
                 O_KS = 106198016, O_VS = 110392320, O_KIS = 114586624, O_CBS = 114717696, O_DS = 115307520, O_FS = 123696128, O_END = 124056576;
constexpr size_t WS_CTL = 0, WS_MOD = 65536, WS_WI = WS_MOD + 1622016, WS_AB = WS_WI + 1179648, WS_BB = WS_AB + 1179648, WS_GL = WS_BB + 1179648,
                 WS_KIP = WS_GL + 18432, WS_KIS = WS_KIP + 2097152, WS_MASKP = WS_KIS + 4456448, WS_MASKS = WS_MASKP + 33554432, WS_WOUT = WS_MASKS + 294912,
                 WS_WGU = WS_WOUT + 8388608, WS_WDN = WS_WGU + 46137344, WS_WIN = WS_WDN + 23068672, WS_H = WS_WIN + 80740352, WS_Q = WS_H + 75497472,
                 WS_KP = WS_Q + 75497472, WS_VP = WS_KP + 67108864, WS_QI = WS_VP + 67108864, WS_QKVB = WS_QI + 37748736, WS_Z = WS_QKVB + 226492416,
                 WS_GA = WS_Z + 75497472, WS_GB = WS_GA + 75497472, WS_R2 = WS_GB + 75497472, WS_END = WS_R2 + 44323328;
constexpr size_t WS_PART = WS_Z;
constexpr size_t WS_SIDEG = WS_GA, WS_SIDEU = WS_GA + (size_t)288 * 4 * 5632 * 4;
constexpr size_t WS_OB = WS_QKVB;
constexpr size_t WS_GP = WS_Q, WS_UP = WS_Q + 207618048;
constexpr int R0_UNITS = 1979, R1_UNITS = 2048;
static_assert(WS_UP + 207618048 <= WS_Z, "ffn buffers overlap");
static_assert(WS_END <= 1073741824ull, "workspace budget");

constexpr int NTHREADS = 512;
constexpr int LDS_BYTES = 155648;
constexpr int MISC_OFF = 155648 - 256;

struct Params { const float* in[27]; float* out; unsigned char* ws; int ph_lo, ph_hi; };

typedef __bf16 bf16x2_n __attribute__((ext_vector_type(2)));
__device__ __forceinline__ unsigned cvt_pk_bf16(float lo, float hi) { const f32x2 f = {lo, hi}; const bf16x2_n v = __builtin_convertvector(f, bf16x2_n); return __builtin_bit_cast(unsigned, v); }
__device__ __forceinline__ bf16_t f2bf(float f) { return (bf16_t)(cvt_pk_bf16(f, 0.f) & 0xffffu); }
__device__ __forceinline__ float bf2f(bf16_t b) { return __uint_as_float(((unsigned)b) << 16); }
__device__ __forceinline__ float bflo(unsigned w) { return __uint_as_float(w << 16); }
__device__ __forceinline__ float bfhi(unsigned w) { return __uint_as_float(w & 0xffff0000u); }
__device__ __forceinline__ float wave_sum(float v) { v += __shfl_xor(v, 32); v += __shfl_xor(v, 16); v += __shfl_xor(v, 8); v += __shfl_xor(v, 4); v += __shfl_xor(v, 2); v += __shfl_xor(v, 1); return v; }
__device__ __forceinline__ float sigmoidf_(float x) { return __builtin_amdgcn_rcpf(1.0f + __expf(-x)); }
__device__ __forceinline__ float siluf_(float x) { return x * __builtin_amdgcn_rcpf(1.0f + __expf(-x)); }
__device__ __forceinline__ int seq_of_row(int m) { return m < SEQ ? 0 : 1 + ((m - SEQ) >> 6); }
__device__ __forceinline__ int crow(int r, int hi) { return (r & 3) + 8 * (r >> 2) + 4 * hi; }
__device__ __forceinline__ unsigned char* unit_ptr(const Params& P, int u) {
    if (u < R0_UNITS) return (unsigned char*)P.out + (size_t)u * UNITB;
    if (u < R0_UNITS + R1_UNITS) return P.ws + WS_WIN + (size_t)(u - R0_UNITS) * UNITB;
    return P.ws + WS_R2 + (size_t)(u - R0_UNITS - R1_UNITS) * UNITB;
}
#define XB_TMO      128
#define XB_XCNT(j)  (256  + 64 * (j))
#define XB_XSUB(j)  (1280 + 64 * (j))
#define XB_XGEN(j)  (2304 + 64 * (j))
#define XB_TOP      3328
#define XB_TOPGEN   3392
#define XCD_BAR_WORDS 3456
#define XB_SPIN_CAP (1u << 18)
#define LAS __attribute__((address_space(3)))

__device__ __forceinline__ unsigned xb_ld(unsigned* p)              { return __hip_atomic_load(p, __ATOMIC_RELAXED, __HIP_MEMORY_SCOPE_AGENT); }
__device__ __forceinline__ unsigned xb_add(unsigned* p, unsigned v) { return __hip_atomic_fetch_add(p, v, __ATOMIC_RELAXED, __HIP_MEMORY_SCOPE_AGENT); }
__device__ __forceinline__ unsigned xb_xcc_id() { return (unsigned)__builtin_amdgcn_s_getreg((3 << 11) | 20) & 0xFu; }
#define XB_SPIN(cond, bar) do { unsigned _sp = 0; while (cond) { __builtin_amdgcn_s_sleep(1); \
    if ((++_sp & 255u) == 0u) { if (xb_ld(&(bar)[XB_TMO])) break; if (_sp > XB_SPIN_CAP) { atomicAdd(&(bar)[XB_TMO], 1u); break; } } } } while (0)

struct XcdBarrier {
    unsigned* bar; unsigned x;
    volatile LAS unsigned* st;
};

__device__ __forceinline__ XcdBarrier xcd_barrier_post(unsigned* bar, volatile LAS unsigned* st) {
    XcdBarrier b; b.bar = bar; b.x = xb_xcc_id(); b.st = st;
    if (threadIdx.x == 0) (void)xb_add(&bar[XB_XCNT(b.x)], 1u);
    return b;
}
__device__ __forceinline__ void xcd_barrier_complete(unsigned* bar, unsigned x, unsigned& nloc, unsigned& nx) {
    const unsigned G = gridDim.x * gridDim.y * gridDim.z;
    unsigned sum, cnt, mine, sp = 0u;
    for (;;) {
        sum = 0u; cnt = 0u; mine = 0u;
#pragma unroll
        for (unsigned j = 0; j < 16; ++j) { const unsigned c = xb_ld(&bar[XB_XCNT(j)]); sum += c; cnt += (c > 0u) ? 1u : 0u; mine = (j == x) ? c : mine; }
        if (sum == G) break;
        __builtin_amdgcn_s_sleep(1);
        if ((++sp & 255u) == 0u) { if (xb_ld(&bar[XB_TMO])) break; if (sp > XB_SPIN_CAP) { atomicAdd(&bar[XB_TMO], 1u); break; } }
    }
    nloc = mine > 0u ? mine : 1u; nx = cnt > 0u ? cnt : 1u;
}

__device__ __forceinline__ void xcd_barrier(const XcdBarrier& b) {
    asm volatile("s_waitcnt vmcnt(0)" ::: "memory");
    __syncthreads();
    if (threadIdx.x == 0) {
        unsigned* bar = b.bar;
        __builtin_amdgcn_s_waitcnt(0);
        unsigned nloc = b.st[0], nx = b.st[1];
        if (nloc == 0u) { xcd_barrier_complete(bar, b.x, nloc, nx); b.st[0] = nloc; b.st[1] = nx; }
        const unsigned old = xb_add(&bar[XB_XSUB(b.x)], 1u);
        const unsigned gen = old / nloc;
        if (old + 1u == (gen + 1u) * nloc) {
            __builtin_amdgcn_fence(__ATOMIC_RELEASE, "agent");
            asm volatile("s_waitcnt vmcnt(0)" ::: "memory");
            const unsigned og = xb_add(&bar[XB_TOP], 1u);
            const unsigned tg = og / nx;
            if (og + 1u == (tg + 1u) * nx) xb_add(&bar[XB_TOPGEN], 1u);
            else XB_SPIN(xb_ld(&bar[XB_TOPGEN]) == tg, bar);
            __builtin_amdgcn_fence(__ATOMIC_ACQUIRE, "agent");
            xb_add(&bar[XB_XGEN(b.x)], 1u);
            asm volatile("s_waitcnt vmcnt(0)" ::: "memory");
        } else {
            XB_SPIN(xb_ld(&bar[XB_XGEN(b.x)]) == gen, bar);
            __builtin_amdgcn_fence(__ATOMIC_ACQUIRE, "agent");
            asm volatile("s_waitcnt vmcnt(0)" ::: "memory");
        }
    }
    __syncthreads();
}
namespace pg8 {
#define PG8_LAS __attribute__((address_space(3)))
typedef unsigned short bf16_t;
typedef short bf16x8 __attribute__((ext_vector_type(8)));
typedef float f32x4 __attribute__((ext_vector_type(4)));
typedef unsigned u32x4 __attribute__((ext_vector_type(4)));
constexpr int BM = 256, BK = 64, HALF = 128, HTB = HALF * BK * 2  , STAGE_BYTES = 8 * HTB, NXCD = 8, WGM = 8;

__host__ __device__ __forceinline__ int lds_byte(int r, int c) { const int st = (r >> 4) * 2 + (c >> 5), rr = r & 15, cc = c & 31, ob = rr * 64 + cc * 2; return st * 1024 + (ob ^ (((ob >> 9) & 1) << 5)); }
__host__ __device__ __forceinline__ void stage_rc(int b, int& R, int& C) { const int st = b / 1024, sb = b % 1024, swz = sb ^ (((sb >> 9) & 1) << 5); R = (st >> 1) * 16 + swz / 64; C = (st & 1) * 32 + (swz % 64) / 2; }
__host__ __device__ __forceinline__ int perm32(int rho) { const int n = rho >> 4, i = rho & 15; return 8 * (i >> 2) + 4 * n + (i & 3); }

struct Unit { int pm, pn, ks; };
struct Gemm { const bf16_t* A; const bf16_t* Bt; int M, N, K; };

struct StaticOrder {
    int nM, nN, nwg, G, c;
    __host__ __device__ void init(int M, int N, int G_, int c_) { nM = M / BM; nN = N / BM; nwg = nM * nN; G = G_; c = c_; }
    __host__ __device__ bool next(int i, Unit& u) const {
        const long L = (long)i * G + c; if (L >= nwg) return false;
        int wgid = (int)L; { const int q = nwg / NXCD, r = nwg % NXCD, xcd = wgid % NXCD, off = wgid / NXCD; wgid = (xcd < r ? xcd * (q + 1) : r * (q + 1) + (xcd - r) * q) + off; }
        const int nig = WGM * nN, gid = wgid / nig, fm = gid * WGM, gsz = (nM - fm) < WGM ? (nM - fm) : WGM;
        u.pm = fm + ((wgid % nig) % gsz); u.pn = (wgid % nig) / gsz; u.ks = 0; return true;
    }
    __device__ __forceinline__ void a_ready(const Unit&) const {}
    __device__ __forceinline__ void done(const Unit&) const {}
};
struct SplitOrder : StaticOrder {
    __host__ __device__ bool next(int i, Unit& u) const {
        if (!(G == 256 && nM == 72 && nN == 8)) return StaticOrder::next(i, u);
        const int x = c & 7, j = c >> 3;
        if (i < 2) { const int off = j + 32 * i; u.pm = 8 * x + (off & 7); u.pn = off >> 3; u.ks = 0; return true; }
        if (i == 2) { u.pm = 64 + (j & 7); u.pn = x; u.ks = 1 + (j >> 3); return true; }
        return false;
    }
};
struct CountedOrder : StaticOrder {
    const unsigned* ready; unsigned need; unsigned* tmo;
    __device__ __forceinline__ void a_ready(const Unit& u) const {
        if (threadIdx.x < 64) {
            const unsigned long long t0 = __builtin_amdgcn_s_memrealtime(); unsigned polls = 0;
            while ((unsigned)__builtin_amdgcn_readfirstlane(__hip_atomic_load(ready + 64 * u.pm, __ATOMIC_RELAXED, __HIP_MEMORY_SCOPE_AGENT)) < need) {
                if ((++polls & 255u) == 0u && __builtin_amdgcn_readfirstlane(__hip_atomic_load(tmo, __ATOMIC_RELAXED, __HIP_MEMORY_SCOPE_AGENT)) != 0u) break;
                if (__builtin_amdgcn_s_memrealtime() - t0 > 2000000ull) {
                    if (threadIdx.x == 0) { unsigned expect = 0u; __hip_atomic_compare_exchange_strong(tmo + 1, &expect, 0x600u | (unsigned)(u.pm & 0xff), __ATOMIC_RELAXED, __ATOMIC_RELAXED, __HIP_MEMORY_SCOPE_AGENT); __hip_atomic_store(tmo, 1u, __ATOMIC_RELAXED, __HIP_MEMORY_SCOPE_AGENT); }
                    break; }
                __builtin_amdgcn_s_sleep(2); }
            __builtin_amdgcn_fence(__ATOMIC_ACQUIRE, "agent");
            asm volatile("s_waitcnt vmcnt(0)" ::: "memory");
        }
#if !defined(BROKEN_HOOK_NO_BARRIER)
        asm volatile("" ::: "memory"); __builtin_amdgcn_s_barrier(); asm volatile("" ::: "memory");
#endif
    }
};
__device__ __forceinline__ u32x4 pack8(const f32x4 a, const f32x4 b) { u32x4 w; w.x = cvt_pk_bf16(a[0], a[1]); w.y = cvt_pk_bf16(a[2], a[3]); w.z = cvt_pk_bf16(b[0], b[1]); w.w = cvt_pk_bf16(b[2], b[3]); return w; }

template <class T> __device__ __forceinline__ void gst(void* p, const T v) { *(__attribute__((address_space(1))) T*)p = v; }
template <class T> __device__ __forceinline__ T gld(const void* p) { return *(const __attribute__((address_space(1))) T*)p; }
struct EpiIn {
    static constexpr bool PERM = true, AFTER_DRAIN = false;
    float* out; unsigned char* ws;
    template <int SEG> __device__ __forceinline__ void seg(const f32x4 (&acc)[2][2][4][2], const Unit& u, int wr, int wc, int fr, int fq, float* outp, unsigned char* wsp) const {
        const int pn = u.pn;
#pragma unroll
        for (int ai = 0; ai < 2; ++ai)
#pragma unroll
            for (int m = 0; m < 4; ++m) {
                const int r = u.pm * BM + ai * HALF + wr * 64 + m * 16 + fr;
                const bool isP = r < SEQ; const int rs = r - SEQ;
#pragma unroll
                for (int bj = 0; bj < 2; ++bj) {
                    const int cb = bj * HALF + wc * 32 + 8 * fq;
                    f32x4 v0 = acc[ai][bj][m][0], v1 = acc[ai][bj][m][1];
                    if (SEG == 0) {
                        gst<u32x4>(((bf16_t*)(wsp + WS_Q) + (size_t)r * DM + pn * 256 + cb), pack8(v0, v1));
                    } else if (SEG == 1) {
                        const bool isK = pn < 16; const int col = (pn - (isK ? 8 : 16)) * 256 + cb;
                        float* dst = outp + (isP ? (isK ? O_KP : O_VP) + (size_t)r * DM : (isK ? O_KS : O_VS) + (size_t)rs * DM) + col;
                        gst<f32x4>(dst, v0); gst<f32x4>((dst + 4), v1);
                        if (isP) gst<u32x4>(((bf16_t*)(wsp + (isK ? WS_KP : WS_VP)) + (size_t)r * DM + col), pack8(v0, v1));
                    } else if (SEG == 2) {
                        gst<u32x4>(((bf16_t*)(wsp + WS_QI) + (size_t)r * 1024 + (pn - 24) * 256 + cb), pack8(v0, v1));
                    } else if (SEG == 3) {
                        const int col = (pn - 28) * 256 + cb;
                        gst<u32x4>(((bf16_t*)(wsp + WS_QKVB) + (size_t)r * CONVB + col), pack8(v0, v1));
                        const int t = isP ? r - (SEQ - 64) : (rs & 63);
                        if (t >= 61 && t < 64) {
                            float* dst = outp + (isP ? O_CBP : O_CBS + (size_t)(rs >> 6) * 3 * CONVB) + (size_t)(t - 61) * CONVB + col;
                            gst<f32x4>(dst, v0); gst<f32x4>((dst + 4), v1);
                        }
                    } else if (SEG == 4) {
                        const int sg = (pn - 52) >> 3; const int col = ((pn - 52) & 7) * 256 + cb;
#pragma unroll
                        for (int j = 0; j < 4; ++j) {
                            if (sg == 0) { v0[j] = siluf_(v0[j]); v1[j] = siluf_(v1[j]); } else { v0[j] = sigmoidf_(v0[j]); v1[j] = sigmoidf_(v1[j]); }
                        }
                        gst<u32x4>(((bf16_t*)(wsp + (sg == 0 ? WS_Z : (sg == 1 ? WS_GA : WS_GB))) + (size_t)r * DM + col), pack8(v0, v1));
                    } else {
                        if (cb < 64) {
                            float* dst = outp + (isP ? O_KIP + (size_t)r * 64 : O_KIS + (size_t)rs * 64) + cb;
                            gst<f32x4>(dst, v0); gst<f32x4>((dst + 4), v1);
                            bf16_t* kb = isP ? (bf16_t*)(wsp + WS_KIP) + (size_t)r * 64 : (bf16_t*)(wsp + WS_KIS) + ((size_t)(rs >> 6) * LS + PAST + (rs & 63)) * 64;
                            gst<u32x4>((kb + cb), pack8(v0, v1));
                        } else if (cb < 112) {
                            const int which = cb < 80 ? 0 : (cb < 96 ? 1 : 2); const int c16 = cb - (which == 0 ? 64 : (which == 1 ? 80 : 96));
                            float* dst = (float*)(wsp + (which == 0 ? WS_WI : (which == 1 ? WS_AB : WS_BB))) + (size_t)r * 16 + c16;
                            const float sc = which == 0 ? 0.03125f : 1.0f;
                            gst<f32x4>(dst, v0 * sc); gst<f32x4>((dst + 4), v1 * sc);
                        }
                    }
                }
            }
    }
    __device__ __forceinline__ void operator()(const f32x4 (&acc)[2][2][4][2], const Unit& u, int wr, int wc, int fr, int fq) const {
        float* outp = out; unsigned char* wsp = ws;
        asm volatile("" : "+s"(outp), "+s"(wsp));
        const int pn = u.pn;
        if (pn < 8) seg<0>(acc, u, wr, wc, fr, fq, outp, wsp);
        else if (pn < 24) seg<1>(acc, u, wr, wc, fr, fq, outp, wsp);
        else if (pn < 28) seg<2>(acc, u, wr, wc, fr, fq, outp, wsp);
        else if (pn < 52) seg<3>(acc, u, wr, wc, fr, fq, outp, wsp);
        else if (pn < 76) seg<4>(acc, u, wr, wc, fr, fq, outp, wsp);
        else seg<5>(acc, u, wr, wc, fr, fq, outp, wsp);
    }
};

template <int WHICH> struct EpiRes {
    static constexpr bool PERM = false, AFTER_DRAIN = false;
    const float* xp; const float* xs; float* Y; const float* mod;
    __device__ __forceinline__ void operator()(const f32x4 (&acc)[2][2][4][2], const Unit& u, int wr, int wc, int fr, int fq) const {
        if (u.ks) {
            float* pp = (float*)((unsigned char*)const_cast<float*>(mod) + (WS_PART - WS_MOD)) + (size_t)(u.ks - 1) * ((size_t)(MT - SEQ) * DM);
#pragma unroll
            for (int ai = 0; ai < 2; ++ai)
#pragma unroll
                for (int m = 0; m < 4; ++m) {
                    float* dst = pp + (size_t)(u.pm * BM + ai * HALF + wr * 64 + m * 16 + fr - SEQ) * DM;
#pragma unroll
                    for (int bj = 0; bj < 2; ++bj)
#pragma unroll
                        for (int n = 0; n < 2; ++n) gst<f32x4>((dst + u.pn * BM + bj * HALF + wc * 32 + n * 16 + 4 * fq), acc[ai][bj][m][n]);
                }
            return;
        }
#pragma unroll
        for (int ai = 0; ai < 2; ++ai)
#pragma unroll
            for (int m = 0; m < 4; ++m) {
                const int r = u.pm * BM + ai * HALF + wr * 64 + m * 16 + fr;
                const int s = seq_of_row(r);
                const float* gate = mod + (size_t)s * 12288 + (WHICH == 0 ? 4096 : 10240);
                const float* base = WHICH == 0 ? (r < SEQ ? xp + (size_t)r * DM : xs + (size_t)(r - SEQ) * DM) : Y + (size_t)r * DM;
                float* dst = Y + (size_t)r * DM;
#pragma unroll
                for (int bj = 0; bj < 2; ++bj)
#pragma unroll
                    for (int n = 0; n < 2; ++n) {
                        const int c = u.pn * BM + bj * HALF + wc * 32 + n * 16 + 4 * fq;
                        const f32x4 g = gld<f32x4>((gate + c)), b = gld<f32x4>((base + c));
                        gst<f32x4>((dst + c), b + g * acc[ai][bj][m][n]);
                    }
            }
    }
};

template <int CTRL> __device__ __forceinline__ float dpp_f(float old, float src) { return __int_as_float(__builtin_amdgcn_update_dpp(__float_as_int(old), __float_as_int(src), CTRL, 0xf, 0xf, false)); }
struct EpiGU {
    static constexpr bool PERM = true, AFTER_DRAIN = false;
    float* out; unsigned char* ws; const float* cw; const float* cb; const float* st;
    __device__ __forceinline__ void operator()(const f32x4 (&acc)[2][2][4][2], const Unit& u, int wr, int wc, int fr, int fq) const {
        float* out = this->out; unsigned char* ws = this->ws; const float* cw = this->cw; const float* cb = this->cb; const float* st = this->st;
        asm volatile("" : "+s"(out), "+s"(ws), "+s"(cw), "+s"(cb), "+s"(st));
        int fr_ = fr; asm volatile("" : "+v"(fr_));
#pragma unroll
        for (int ai = 0; ai < 2; ++ai) {
            const int R0 = u.pm * BM + ai * HALF + wr * 64; const bool isP = R0 < SEQ;
            unsigned pk0[4][2];
#pragma unroll
            for (int hc = 0; hc < 2; ++hc) {
                const int f = u.pn * 128 + wc * 32 + 8 * fq + 4 * hc;
                const f32x4 w0 = gld<f32x4>((cw + f)), w1 = gld<f32x4>((cw + DFF + f)), w2 = gld<f32x4>((cw + 2 * DFF + f)), bb = gld<f32x4>((cb + f));
                f32x4 cprev = {0.f, 0.f, 0.f, 0.f};
                if (!isP) { const float* sp = st + (size_t)((R0 - SEQ) >> 6) * 2 * DFF + f; const f32x4 s0 = gld<f32x4>(sp), s1 = gld<f32x4>((sp + DFF)); cprev = fr_ == 14 ? s0 : s1; }
#pragma unroll
                for (int m = 0; m < 4; ++m) {
                    const f32x4 g = acc[ai][0][m][hc], up = acc[ai][1][m][hc]; const f32x4 gp = m == 0 ? cprev : acc[ai][0][m - 1][hc];
                    const int r = R0 + m * 16 + fr_;
                    f32x4 y;
#pragma unroll
                    for (int q = 0; q < 4; ++q) {
                        const float p1 = dpp_f<0x111>(dpp_f<0x10F>(0.f, gp[q]), g[q]);
                        const float p2 = dpp_f<0x112>(dpp_f<0x10E>(0.f, gp[q]), g[q]);
                        const float a = fmaf(w0[q], p2, fmaf(w1[q], p1, fmaf(w2[q], g[q], bb[q])));
                        y[q] = siluf_(a) * up[q];
                    }
                    const unsigned y01 = cvt_pk_bf16(y[0], y[1]), y23 = cvt_pk_bf16(y[2], y[3]);
                    if (hc == 0) { pk0[m][0] = y01; pk0[m][1] = y23; }
                    else { u32x4 o; o.x = pk0[m][0]; o.y = pk0[m][1]; o.z = y01; o.w = y23; gst<u32x4>(((bf16_t*)(ws + WS_UP) + (size_t)r * DFF + f - 4), o); }
                    if (m == 0 || m == 3) {
                        const int t = m * 16 + fr_;
                        if (isP && (t < 2 || t >= 62)) {
                            gst<f32x4>(((float*)(ws + WS_SIDEG) + ((size_t)(r >> 6) * 4 + ((t + 2) & 3)) * DFF + f), g);
                            if (t < 2) gst<f32x4>(((float*)(ws + WS_SIDEU) + ((size_t)(r >> 6) * 2 + t) * DFF + f), up);
                        }
                        if (m == 3 && t >= 62 && (!isP || R0 == SEQ - 64))
                            gst<f32x4>((out + (isP ? O_FP : O_FS + (size_t)((R0 - SEQ) >> 6) * 2 * DFF) + (size_t)(t - 62) * DFF + f), g);
                    }
                }
            }
        }
    }
};

template <class Epi, class Sched, bool STAMP = false>
__device__ __forceinline__ void gemm_phase(PG8_LAS unsigned char* lds, const Gemm g, const Sched& S, const Epi& E, unsigned long long* stamps) {
    int tid_ = threadIdx.x; asm volatile("" : "+v"(tid_));
    const int tid = tid_, wid = __builtin_amdgcn_readfirstlane(tid >> 6), lane = tid & 63, wr = wid >> 2, wc = wid & 3, fr = lane & 15, fq = lane >> 4;
    const int K = g.K, nt = K / BK;
    int ts_lo = 0, ts_hi = 0, nts = 0; const unsigned long long rt_entry = STAMP ? (unsigned long long)wall_clock64() : 0ull;
#define PG8_STAMP() do { if (STAMP && wid == 0 && nts < 64) { const unsigned long long _c = (unsigned long long)clock64(); \
        ts_lo = (lane == nts) ? (int)(unsigned)_c : ts_lo; ts_hi = (lane == nts) ? (int)(unsigned)(_c >> 32) : ts_hi; ++nts; } } while (0)
    PG8_STAMP();
    unsigned voffA[2], voffB[2];
#pragma unroll
    for (int i = 0; i < 2; ++i) { int R, C; stage_rc(tid * 16 + i * 8192, R, C); const int Rb = Epi::PERM ? ((R & ~31) + perm32(R & 31)) : R;
        voffA[i] = (unsigned)(R * K + C) * 2u; voffB[i] = (unsigned)(Rb * K + C) * 2u; }
    const size_t kstep = (size_t)(BK * 2);
    const size_t hstep = (size_t)HALF * K * 2;
    const size_t tstep = 2 * hstep;
    auto koff = [&](const Unit& u) -> size_t { return u.ks ? (size_t)((u.ks - 1) * (nt >> 2)) * kstep : (size_t)0; };
    const unsigned ldsw = (unsigned)wid * 1024u;
    const int aoff = lds_byte(wr * 64 + fr, fq * 8), boff = lds_byte(wc * 32 + fr, fq * 8);
#define PG8_SA(b, h) (((b) * 2 + (h)) * HTB)
#define PG8_SB(b, h) ((4 + (b) * 2 + (h)) * HTB)
#define PG8_STAGE(bufoff, gbase, voff) do { _Pragma("unroll") for (int _i = 0; _i < 2; ++_i) \
        __builtin_amdgcn_global_load_lds((const unsigned*)((const char*)(gbase) + (voff)[_i]), (PG8_LAS unsigned*)(lds + (bufoff) + ldsw + _i * 8192), 16, 0, 0); } while (0)
#define PG8_LDA(dst, b, h) do { _Pragma("unroll") for (int m = 0; m < 4; ++m) _Pragma("unroll") for (int k = 0; k < 2; ++k) dst[m][k] = *(const PG8_LAS bf16x8*)(lds + PG8_SA(b, h) + aoff + m * 2048 + k * 1024); } while (0)
#define PG8_LDB(dst, b, h) do { _Pragma("unroll") for (int n = 0; n < 2; ++n) _Pragma("unroll") for (int k = 0; k < 2; ++k) dst[n][k] = *(const PG8_LAS bf16x8*)(lds + PG8_SB(b, h) + boff + n * 2048 + k * 1024); } while (0)
#define PG8_MMA(ai, bj, At, Bt) do { __builtin_amdgcn_s_setprio(1); _Pragma("unroll") for (int m = 0; m < 4; ++m) _Pragma("unroll") for (int n = 0; n < 2; ++n) _Pragma("unroll") for (int k = 0; k < 2; ++k) \
        acc[ai][bj][m][n] = __builtin_amdgcn_mfma_f32_16x16x32_bf16(Bt[n][k], At[m][k], acc[ai][bj][m][n], 0, 0, 0); __builtin_amdgcn_s_setprio(0); } while (0)
#define PG8_WAIT_V(n) asm volatile("s_waitcnt vmcnt(" #n ")" ::: "memory")
#define PG8_WAIT_L(n) asm volatile("s_waitcnt lgkmcnt(" #n ")" ::: "memory")
#define PG8_BAR __builtin_amdgcn_s_barrier()
#define PG8_SCHED __builtin_amdgcn_sched_barrier(0)
    Unit cur, nxt; int ui = 0;
    if (!S.next(0, cur)) return;
    f32x4 acc[2][2][4][2];
#pragma unroll
    for (int a = 0; a < 2; ++a)
#pragma unroll
        for (int b = 0; b < 2; ++b)
#pragma unroll
            for (int m = 0; m < 4; ++m)
#pragma unroll
                for (int n = 0; n < 2; ++n) acc[a][b][m][n] = (f32x4){0.f, 0.f, 0.f, 0.f};
    bf16x8 At[4][2], B0[2][2], B1[2][2];
    const char* cA = (const char*)g.A + (size_t)cur.pm * tstep + koff(cur); const char* cB = (const char*)g.Bt + (size_t)cur.pn * tstep + koff(cur);
    S.a_ready(cur);
    PG8_STAGE(PG8_SB(0, 0), cB, voffB); PG8_STAGE(PG8_SA(0, 0), cA, voffA); PG8_STAGE(PG8_SB(0, 1), cB + hstep, voffB); PG8_STAGE(PG8_SA(0, 1), cA + hstep, voffA);
    if (wr == 1) PG8_BAR;
    PG8_WAIT_V(4); PG8_BAR;
    PG8_STAGE(PG8_SB(1, 0), cB + kstep, voffB); PG8_STAGE(PG8_SA(1, 0), cA + kstep, voffA); PG8_STAGE(PG8_SB(1, 1), cB + hstep + kstep, voffB);
    PG8_WAIT_V(6); PG8_BAR;
    PG8_STAMP();
    for (;;) {
        const bool has_next = S.next(ui + 1, nxt);
        const char* nA = has_next ? (const char*)g.A + (size_t)nxt.pm * tstep + koff(nxt) : cA; const char* nB = has_next ? (const char*)g.Bt + (size_t)nxt.pn * tstep + koff(nxt) : cB;
        const int unt = cur.ks ? (nt >> 2) : nt;
        for (int t = 0; t < unt; t += 2) {
            const bool last = (t == unt - 2);
            const char* a1 = cA + (size_t)(t + 1) * kstep;
            const char* a2 = last ? nA : cA + (size_t)(t + 2) * kstep; const char* b2 = last ? nB : cB + (size_t)(t + 2) * kstep;
            const char* a3 = a2 + kstep; const char* b3 = b2 + kstep;
            if (last && has_next) S.a_ready(nxt);
            PG8_LDB(B0, 0, 0); PG8_SCHED; PG8_LDA(At, 0, 0); PG8_STAGE(PG8_SA(1, 1), a1 + hstep, voffA);
            PG8_WAIT_L(8); PG8_BAR; PG8_WAIT_L(0); PG8_MMA(0, 0, At, B0); PG8_BAR; PG8_SCHED;
            PG8_LDB(B1, 0, 1); PG8_STAGE(PG8_SB(0, 0), b2, voffB);
            PG8_BAR; PG8_WAIT_L(0); PG8_MMA(0, 1, At, B1); PG8_BAR;
            PG8_LDA(At, 0, 1); PG8_STAGE(PG8_SA(0, 0), a2, voffA);
            PG8_BAR; PG8_WAIT_L(0); PG8_MMA(1, 0, At, B0); PG8_BAR; PG8_SCHED;
            PG8_STAGE(PG8_SB(0, 1), b2 + hstep, voffB);
            PG8_WAIT_V(6); PG8_BAR; PG8_MMA(1, 1, At, B1); PG8_BAR;
            PG8_LDB(B0, 1, 0); PG8_SCHED; PG8_LDA(At, 1, 0); PG8_STAGE(PG8_SA(0, 1), a2 + hstep, voffA);
            PG8_WAIT_L(8); PG8_BAR; PG8_WAIT_L(0); PG8_MMA(0, 0, At, B0); PG8_BAR; PG8_SCHED;
            PG8_LDB(B1, 1, 1); PG8_STAGE(PG8_SB(1, 0), b3, voffB);
            PG8_BAR; PG8_WAIT_L(0); PG8_MMA(0, 1, At, B1); PG8_BAR;
            PG8_LDA(At, 1, 1); PG8_STAGE(PG8_SA(1, 0), a3, voffA);
            PG8_BAR; PG8_WAIT_L(0); PG8_MMA(1, 0, At, B0); PG8_BAR; PG8_SCHED;
            PG8_STAGE(PG8_SB(1, 1), b3 + hstep, voffB);
            PG8_WAIT_V(6); PG8_BAR; PG8_MMA(1, 1, At, B1); PG8_BAR;
        }
        PG8_STAMP();
        if constexpr (!Epi::AFTER_DRAIN) { E(acc, cur, wr, wc, fr, fq); S.done(cur); }
        PG8_STAMP();
        if (!has_next) break;
#pragma unroll
        for (int a = 0; a < 2; ++a)
#pragma unroll
            for (int b = 0; b < 2; ++b)
#pragma unroll
                for (int m = 0; m < 4; ++m)
#pragma unroll
                    for (int n = 0; n < 2; ++n) acc[a][b][m][n] = (f32x4){0.f, 0.f, 0.f, 0.f};
        cur = nxt; cA = nA; cB = nB; ++ui;
    }
    PG8_WAIT_V(0);
    if (wr == 0) PG8_BAR;
    PG8_BAR;
    if constexpr (Epi::AFTER_DRAIN) { E.fused(acc, cur, wr, wc, fr, fq, lds, wid, lane); S.done(cur); }
    PG8_STAMP();
    if (STAMP && wid == 0) { stamps[lane] = lane < nts ? (((unsigned long long)(unsigned)ts_hi << 32) | (unsigned)ts_lo) : 0ull;
        if (lane == 62) stamps[62] = rt_entry; if (lane == 63) stamps[63] = (unsigned long long)wall_clock64(); }
#undef PG8_STAMP
#undef PG8_SA
#undef PG8_SB
#undef PG8_STAGE
#undef PG8_LDA
#undef PG8_LDB
#undef PG8_MMA
#undef PG8_WAIT_V
#undef PG8_WAIT_L
#undef PG8_BAR
#undef PG8_SCHED
}
}
__device__ __forceinline__ void adaln_phase(const Params& P, LAS unsigned char* lds) {
    int tid = threadIdx.x; asm volatile("" : "+v"(tid)); const int w = tid >> 6, lane = tid & 63;
    LAS float* sc = (LAS float*)lds;
    LAS float* red = (LAS float*)(lds + 33792);
    const float* cp = P.in[2]; const float* cs = P.in[3]; const float* wada = P.in[12]; const float* bada = P.in[13];
    float* mod = (float*)(P.ws + WS_MOD);
    for (int j = blockIdx.x; j < 192; j += gridDim.x) {
        float acc[NSEQ];
#pragma unroll
        for (int s = 0; s < NSEQ; ++s) acc[s] = 0.f;
        for (int kc = 0; kc < 8; ++kc) {
            const int k0 = kc * 256;
            __syncthreads();
            for (int idx = tid; idx < NSEQ * 256; idx += NTHREADS) {
                const int s = idx >> 8, kk = idx & 255;
                const float c = s == 0 ? cp[k0 + kk] : cs[(size_t)(s - 1) * DM + k0 + kk];
                sc[idx] = c / (1.0f + expf(-c));
            }
            __syncthreads();
            for (int kk = 0; kk < 32; kk += 4) {
                float wv[4];
#pragma unroll
                for (int q = 0; q < 4; ++q) wv[q] = wada[(size_t)(k0 + 32 * w + kk + q) * 12288 + 64 * j + lane];
#pragma unroll
                for (int s = 0; s < NSEQ; ++s) {
                    const f32x4 c4 = *(const LAS f32x4*)(sc + s * 256 + 32 * w + kk);
                    acc[s] = fmaf(c4[0], wv[0], acc[s]); acc[s] = fmaf(c4[1], wv[1], acc[s]); acc[s] = fmaf(c4[2], wv[2], acc[s]); acc[s] = fmaf(c4[3], wv[3], acc[s]);
                }
            }
        }
#pragma unroll
        for (int s = 0; s < NSEQ; ++s) red[(w * NSEQ + s) * 64 + lane] = acc[s];
        __syncthreads();
        for (int idx = tid; idx < NSEQ * 64; idx += NTHREADS) {
            const int s = idx >> 6, col = idx & 63; float v = bada[64 * j + col];
#pragma unroll
            for (int ww = 0; ww < 8; ++ww) v += red[(ww * NSEQ + s) * 64 + col];
            mod[(size_t)s * 12288 + 64 * j + col] = v;
        }
        __syncthreads();
    }
}

__device__ __forceinline__ int win_src_col(int n) {
    if (n < 7168) return n;
    if (n < 13312) return 7248 + (n - 7168);
    if (n < 19456) return 13424 + (n - 13312);
    const int q = n - 19456;
    if (q < 80) return 7168 + q;
    if (q < 112) return 13392 + (q - 80);
    return -1;
}
__device__ __forceinline__ void xpose_jobs(const Params& P, LAS unsigned char* lds, const int jlo, const int jhi, const int first, const int stride) {
    int tid = threadIdx.x; asm volatile("" : "+v"(tid)); const int tx = tid & 63, ty = tid >> 6, nl = tid >> 3, ks = tid & 7;
    LAS float* tile = (LAS float*)lds;
    constexpr int J0 = 77 * 32, J1 = J0 + 8 * 32, J2 = J1 + 44 * 32, J3 = J2 + 8 * 88;
    for (int j = jlo + first; j < jhi; j += stride) {
        const float* src0; const float* src1; int ld, K, nt, kt, which; bf16_t* dst;
        if (j < J0)      { nt = j >> 5; kt = j & 31; src0 = src1 = P.in[15]; ld = DIN; K = DM; dst = (bf16_t*)(P.ws + WS_WIN); which = 0; }
        else if (j < J1) { const int q = j - J0; nt = q >> 5; kt = q & 31; src0 = src1 = P.in[20]; ld = DM; K = DM; dst = (bf16_t*)(P.ws + WS_WOUT); which = 1; }
        else if (j < J2) { const int q = j - J1; nt = q >> 5; kt = q & 31; src0 = P.in[22]; src1 = P.in[25]; K = DM; ld = DFF; dst = (bf16_t*)(P.ws + WS_WGU); which = 2; }
        else             { const int q = j - J2; nt = q / 88; kt = q % 88; src0 = src1 = P.in[26]; ld = DM; K = DFF; dst = (bf16_t*)(P.ws + WS_WDN); which = 1; }
        const int k0 = kt * 64;
        float v[32];
#pragma unroll
        for (int c = 0; c < 4; ++c) {
            const int n = nt * 256 + c * 64 + tx;
            const int sc = which == 0 ? win_src_col(n) : (which == 2 ? nt * 128 + ((c & 1) * 64 + tx) : n);
            const float* sp = (which == 2 && c >= 2) ? src1 : src0;
#pragma unroll
            for (int i = 0; i < 8; ++i) v[c * 8 + i] = sc >= 0 ? sp[(size_t)(k0 + ty + 8 * i) * ld + sc] : 0.f;
        }
#pragma unroll
        for (int c = 0; c < 4; ++c)
#pragma unroll
            for (int i = 0; i < 8; ++i) tile[(ty + 8 * i) * 257 + c * 64 + tx] = v[c * 8 + i];
        __syncthreads();
#pragma unroll
        for (int c = 0; c < 4; ++c) {
            float o[8];
#pragma unroll
            for (int q = 0; q < 8; ++q) o[q] = tile[(ks * 8 + q) * 257 + c * 64 + nl];
            u32x4 wv; wv.x = cvt_pk_bf16(o[0], o[1]); wv.y = cvt_pk_bf16(o[2], o[3]); wv.z = cvt_pk_bf16(o[4], o[5]); wv.w = cvt_pk_bf16(o[6], o[7]);
            *(u32x4*)(dst + (size_t)(nt * 256 + c * 64 + nl) * K + k0 + ks * 8) = wv;
        }
        __syncthreads();
    }
}
constexpr int XP_J0 = 77 * 32, XP_J1 = XP_J0 + 8 * 32, XP_J2 = XP_J1 + 44 * 32, XP_J3 = XP_J2 + 8 * 88, XP_GU_DEFER = 352;
__device__ __forceinline__ bool xpose_deferred() { return gridDim.x == 256; }
__device__ __forceinline__ void xpose_phase(const Params& P, LAS unsigned char* lds) {
    const int G = (int)gridDim.x, bx = (int)blockIdx.x;
    if (!xpose_deferred()) { xpose_jobs(P, lds, 0, XP_J3, bx, G); return; }
    xpose_jobs(P, lds, 0, XP_J0, bx, G);
    xpose_jobs(P, lds, XP_J1 + XP_GU_DEFER, XP_J2, ((bx - XP_J0 % G) % G + G) % G, G);
}
__device__ __forceinline__ void xpose_tail_inproj(const Params& P, LAS unsigned char* lds) {
    if (xpose_deferred() && blockIdx.x >= 168) xpose_jobs(P, lds, XP_J0, XP_J1 + XP_GU_DEFER, (int)blockIdx.x - 168, 88);
}
__device__ __forceinline__ void xpose_tail_gateup(const Params& P, LAS unsigned char* lds) {
    if (xpose_deferred() && blockIdx.x >= 96) xpose_jobs(P, lds, XP_J2, XP_J3, (int)blockIdx.x - 96, 160);
}

__device__ __forceinline__ bool split_on() { return gridDim.x == 256; }
template <int WHICH> __device__ __forceinline__ void normmod_phase(const Params& P) {
    int tid = threadIdx.x; asm volatile("" : "+v"(tid)); const int w = tid >> 6, lane = tid & 63;
    const float* g = P.in[WHICH == 0 ? 14 : 21]; const float* mod = (const float*)(P.ws + WS_MOD);
    bf16_t* H = (bf16_t*)(P.ws + WS_H);
    for (int row = blockIdx.x * 8 + w; row < MT; row += gridDim.x * 8) {
        const float* src = WHICH == 0 ? (row < SEQ ? P.in[0] + (size_t)row * DM : P.in[1] + (size_t)(row - SEQ) * DM) : P.out + (size_t)row * DM;
        const int s = seq_of_row(row);
        const float* sh = mod + (size_t)s * 12288 + (WHICH == 0 ? 0 : 6144); const float* sl = sh + 2048;
        f32x4 v[8]; float ss = 0.f;
        if (WHICH == 1 && row >= SEQ && split_on()) {
            const float* pp = (const float*)(P.ws + WS_PART) + (size_t)(row - SEQ) * DM; const float* xs = P.in[1] + (size_t)(row - SEQ) * DM; const float* gt = mod + (size_t)s * 12288 + 4096;
            float* Yr = P.out + (size_t)row * DM;
#pragma unroll
            for (int j = 0; j < 8; ++j) {
                const int c = lane * 4 + 256 * j; constexpr size_t PS = (size_t)(MT - SEQ) * DM;
                const f32x4 a = ((*(const f32x4*)(pp + c) + *(const f32x4*)(pp + PS + c)) + *(const f32x4*)(pp + 2 * PS + c)) + *(const f32x4*)(pp + 3 * PS + c);
                v[j] = *(const f32x4*)(xs + c) + *(const f32x4*)(gt + c) * a; *(f32x4*)(Yr + c) = v[j];
                ss += v[j][0] * v[j][0] + v[j][1] * v[j][1] + v[j][2] * v[j][2] + v[j][3] * v[j][3];
            }
        } else {
#pragma unroll
            for (int j = 0; j < 8; ++j) { v[j] = *(const f32x4*)(src + lane * 4 + 256 * j); ss += v[j][0] * v[j][0] + v[j][1] * v[j][1] + v[j][2] * v[j][2] + v[j][3] * v[j][3]; }
        }
        ss = wave_sum(ss);
        const float rstd = rsqrtf(ss * (1.0f / DM) + 1e-6f);
#pragma unroll
        for (int j = 0; j < 8; ++j) {
            const int c = lane * 4 + 256 * j;
            const f32x4 gg = *(const f32x4*)(g + c), a = *(const f32x4*)(sl + c), b = *(const f32x4*)(sh + c);
            const f32x4 y = (v[j] * rstd * gg) * (1.0f + a) + b;
            u32x2 o; o.x = cvt_pk_bf16(y[0], y[1]); o.y = cvt_pk_bf16(y[2], y[3]);
            *(u32x2*)(H + (size_t)row * DM + c) = o;
        }
    }
}

__device__ __forceinline__ void finalnorm_phase(const Params& P) {
    int tid = threadIdx.x; asm volatile("" : "+v"(tid)); const int w = tid >> 6, lane = tid & 63;
    const float* g = P.in[11];
    for (int row = blockIdx.x * 8 + w; row < MT; row += gridDim.x * 8) {
        float* src = P.out + (size_t)row * DM;
        f32x4 v[8]; float ss = 0.f;
        if (row >= SEQ && split_on()) {
            const float* pp = (const float*)(P.ws + WS_PART) + (size_t)(row - SEQ) * DM; const float* gt = (const float*)(P.ws + WS_MOD) + (size_t)seq_of_row(row) * 12288 + 10240;
#pragma unroll
            for (int j = 0; j < 8; ++j) {
                const int c = lane * 4 + 256 * j; constexpr size_t PS = (size_t)(MT - SEQ) * DM;
                const f32x4 a = ((*(const f32x4*)(pp + c) + *(const f32x4*)(pp + PS + c)) + *(const f32x4*)(pp + 2 * PS + c)) + *(const f32x4*)(pp + 3 * PS + c);
                v[j] = *(const f32x4*)(src + c) + *(const f32x4*)(gt + c) * a;
                ss += v[j][0] * v[j][0] + v[j][1] * v[j][1] + v[j][2] * v[j][2] + v[j][3] * v[j][3];
            }
        } else {
#pragma unroll
            for (int j = 0; j < 8; ++j) { v[j] = *(const f32x4*)(src + lane * 4 + 256 * j); ss += v[j][0] * v[j][0] + v[j][1] * v[j][1] + v[j][2] * v[j][2] + v[j][3] * v[j][3]; }
        }
        ss = wave_sum(ss);
        const float rstd = rsqrtf(ss * (1.0f / DM) + 1e-6f);
#pragma unroll
        for (int j = 0; j < 8; ++j) { const int c = lane * 4 + 256 * j; *(f32x4*)(src + c) = v[j] * rstd * *(const f32x4*)(g + c); }
    }
}

__device__ __forceinline__ void ffn_seam_phase(const Params& P) {
    const float* SG = (const float*)(P.ws + WS_SIDEG); const float* SU = (const float*)(P.ws + WS_SIDEU); bf16_t* UP = (bf16_t*)(P.ws + WS_UP);
    const float* cw = P.in[23]; const float* cb = P.in[24];
    constexpr int NC4 = DFF / 4;
    int tid_ = threadIdx.x; asm volatile("" : "+v"(tid_));
    for (int task = blockIdx.x * NTHREADS + tid_; task < 255 * NC4; task += gridDim.x * NTHREADS) {
        const int k = 1 + task / NC4, f = (task % NC4) * 4;
        const f32x4 w0 = *(const f32x4*)(cw + f), w1 = *(const f32x4*)(cw + DFF + f), w2 = *(const f32x4*)(cw + 2 * DFF + f), bb = *(const f32x4*)(cb + f);
        const f32x4 xm2 = *(const f32x4*)(SG + ((size_t)(k - 1) * 4 + 0) * DFF + f), xm1 = *(const f32x4*)(SG + ((size_t)(k - 1) * 4 + 1) * DFF + f);
        const f32x4 x0 = *(const f32x4*)(SG + ((size_t)k * 4 + 2) * DFF + f), x1 = *(const f32x4*)(SG + ((size_t)k * 4 + 3) * DFF + f);
        const f32x4 u0 = *(const f32x4*)(SU + ((size_t)k * 2 + 0) * DFF + f), u1 = *(const f32x4*)(SU + ((size_t)k * 2 + 1) * DFF + f);
        f32x4 y0, y1;
#pragma unroll
        for (int q = 0; q < 4; ++q) {
            y0[q] = siluf_(fmaf(w0[q], xm2[q], fmaf(w1[q], xm1[q], fmaf(w2[q], x0[q], bb[q])))) * u0[q];
            y1[q] = siluf_(fmaf(w0[q], xm1[q], fmaf(w1[q], x0[q], fmaf(w2[q], x1[q], bb[q])))) * u1[q];
        }
        u32x2 o0, o1; o0.x = cvt_pk_bf16(y0[0], y0[1]); o0.y = cvt_pk_bf16(y0[2], y0[3]); o1.x = cvt_pk_bf16(y1[0], y1[1]); o1.y = cvt_pk_bf16(y1[2], y1[3]);
        *(u32x2*)(UP + (size_t)(64 * k) * DFF + f) = o0; *(u32x2*)(UP + (size_t)(64 * k + 1) * DFF + f) = o1;
    }
}

__device__ __forceinline__ void act_phase(const Params& P) {
    const bf16_t* GP = (const bf16_t*)(P.ws + WS_GP); bf16_t* UP = (bf16_t*)(P.ws + WS_UP);
    const float* cw = P.in[23]; const float* cb = P.in[24]; const float* st = P.in[9];
    constexpr int NCG = DFF / 8, NRB = MT / 32;
    int tid_ = threadIdx.x; asm volatile("" : "+v"(tid_));
    for (int task = blockIdx.x * NTHREADS + tid_; task < NCG * NRB; task += gridDim.x * NTHREADS) {
        const int cg = task % NCG, rb = task / NCG, f = cg * 8, m0 = rb * 32;
        float w0[8], w1[8], w2[8], bb[8], xm2[8], xm1[8];
#pragma unroll
        for (int q = 0; q < 8; ++q) { w0[q] = cw[f + q]; w1[q] = cw[DFF + f + q]; w2[q] = cw[2 * DFF + f + q]; bb[q] = cb[f + q]; }
        const bool isP = m0 < SEQ; const int t0 = isP ? m0 : ((m0 - SEQ) & 63);
        if (t0 == 0) {
            if (isP) {
#pragma unroll
                for (int q = 0; q < 8; ++q) { xm2[q] = 0.f; xm1[q] = 0.f; }
            } else {
                const float* sp = st + (size_t)((m0 - SEQ) >> 6) * 2 * DFF + f;
#pragma unroll
                for (int q = 0; q < 8; ++q) { xm2[q] = sp[q]; xm1[q] = sp[DFF + q]; }
            }
        } else {
            const u32x4 a = *(const u32x4*)(GP + (size_t)(m0 - 2) * DFF + f), b = *(const u32x4*)(GP + (size_t)(m0 - 1) * DFF + f);
            xm2[0] = bflo(a.x); xm2[1] = bfhi(a.x); xm2[2] = bflo(a.y); xm2[3] = bfhi(a.y); xm2[4] = bflo(a.z); xm2[5] = bfhi(a.z); xm2[6] = bflo(a.w); xm2[7] = bfhi(a.w);
            xm1[0] = bflo(b.x); xm1[1] = bfhi(b.x); xm1[2] = bflo(b.y); xm1[3] = bfhi(b.y); xm1[4] = bflo(b.z); xm1[5] = bfhi(b.z); xm1[6] = bflo(b.w); xm1[7] = bfhi(b.w);
        }
#pragma unroll 1
        for (int ib = 0; ib < 32; ib += 8) {
            u32x4 gq[8], uq[8];
#pragma unroll
            for (int i = 0; i < 8; ++i) { const size_t off = (size_t)(m0 + ib + i) * DFF + f; gq[i] = *(const u32x4*)(GP + off); uq[i] = *(const u32x4*)(UP + off); }
#pragma unroll
            for (int i = 0; i < 8; ++i) {
                float x0[8], uu[8], y[8];
                x0[0] = bflo(gq[i].x); x0[1] = bfhi(gq[i].x); x0[2] = bflo(gq[i].y); x0[3] = bfhi(gq[i].y); x0[4] = bflo(gq[i].z); x0[5] = bfhi(gq[i].z); x0[6] = bflo(gq[i].w); x0[7] = bfhi(gq[i].w);
                uu[0] = bflo(uq[i].x); uu[1] = bfhi(uq[i].x); uu[2] = bflo(uq[i].y); uu[3] = bfhi(uq[i].y); uu[4] = bflo(uq[i].z); uu[5] = bfhi(uq[i].z); uu[6] = bflo(uq[i].w); uu[7] = bfhi(uq[i].w);
#pragma unroll
                for (int q = 0; q < 8; ++q) { const float a = fmaf(w0[q], xm2[q], fmaf(w1[q], xm1[q], fmaf(w2[q], x0[q], bb[q]))); y[q] = siluf_(a) * uu[q]; xm2[q] = xm1[q]; xm1[q] = x0[q]; }
                u32x4 o; o.x = cvt_pk_bf16(y[0], y[1]); o.y = cvt_pk_bf16(y[2], y[3]); o.z = cvt_pk_bf16(y[4], y[5]); o.w = cvt_pk_bf16(y[6], y[7]);
                *(u32x4*)(UP + (size_t)(m0 + ib + i) * DFF + f) = o;
            }
        }
    }
}

__device__ __forceinline__ void merge_phase(const Params& P) {
    const bf16_t* OA = (const bf16_t*)(P.ws + WS_H); const bf16_t* OB = (const bf16_t*)(P.ws + WS_OB);
    const bf16_t* Z = (const bf16_t*)(P.ws + WS_Z); const bf16_t* GA = (const bf16_t*)(P.ws + WS_GA); const bf16_t* GB = (const bf16_t*)(P.ws + WS_GB);
    const float* gdn = P.in[19]; bf16_t* MIX = (bf16_t*)(P.ws + WS_H);
    const size_t total = (size_t)MT * DM / 8;
    int tid_ = threadIdx.x; asm volatile("" : "+v"(tid_));
    for (size_t task = (size_t)blockIdx.x * NTHREADS + tid_; task < total; task += (size_t)gridDim.x * NTHREADS) {
        const size_t off = task * 8; const int dv = (int)(off & 127);
        const u32x4 oa = *(const u32x4*)(OA + off), ob = *(const u32x4*)(OB + off), z = *(const u32x4*)(Z + off), ga = *(const u32x4*)(GA + off), gb = *(const u32x4*)(GB + off);
        float b[8] = {bflo(ob.x), bfhi(ob.x), bflo(ob.y), bfhi(ob.y), bflo(ob.z), bfhi(ob.z), bflo(ob.w), bfhi(ob.w)};
        float ss = 0.f;
#pragma unroll
        for (int q = 0; q < 8; ++q) ss += b[q] * b[q];
        ss += __shfl_xor(ss, 1); ss += __shfl_xor(ss, 2); ss += __shfl_xor(ss, 4); ss += __shfl_xor(ss, 8);
        const float rstd = rsqrtf(ss * (1.0f / 128.0f) + 1e-6f);
        const float a[8] = {bflo(oa.x), bfhi(oa.x), bflo(oa.y), bfhi(oa.y), bflo(oa.z), bfhi(oa.z), bflo(oa.w), bfhi(oa.w)};
        const float zz[8] = {bflo(z.x), bfhi(z.x), bflo(z.y), bfhi(z.y), bflo(z.z), bfhi(z.z), bflo(z.w), bfhi(z.w)};
        const float g1[8] = {bflo(ga.x), bfhi(ga.x), bflo(ga.y), bfhi(ga.y), bflo(ga.z), bfhi(ga.z), bflo(ga.w), bfhi(ga.w)};
        const float g2[8] = {bflo(gb.x), bfhi(gb.x), bflo(gb.y), bfhi(gb.y), bflo(gb.z), bfhi(gb.z), bflo(gb.w), bfhi(gb.w)};
        float y[8];
#pragma unroll
        for (int q = 0; q < 8; ++q) y[q] = g1[q] * a[q] + g2[q] * (b[q] * rstd * gdn[dv + q] * zz[q]);
        u32x4 o; o.x = cvt_pk_bf16(y[0], y[1]); o.y = cvt_pk_bf16(y[2], y[3]); o.z = cvt_pk_bf16(y[4], y[5]); o.w = cvt_pk_bf16(y[6], y[7]);
        *(u32x4*)(MIX + off) = o;
    }
}
__device__ __forceinline__ void d1_phase(const Params& P, LAS unsigned char* lds) {
    const int grp = threadIdx.x >> 8;
    LAS unsigned char* base = lds + grp * 53248;
    LAS unsigned char* Kraw = base;
    LAS unsigned char* Qraw = base + 16384;
    LAS float* Ml = (LAS float*)(base + 32768);
    LAS float* GC = (LAS float*)(base + 49152); LAS float* BETA = GC + 64; LAS float* EG = GC + 128; LAS float* EKD = GC + 192; LAS float* RK = GC + 256; LAS float* RQ = GC + 320;
    const bf16_t* QKVB = (const bf16_t*)(P.ws + WS_QKVB);
    const float* ABp = (const float*)(P.ws + WS_AB); const float* BBp = (const float*)(P.ws + WS_BB); float* GL = (float*)(P.ws + WS_GL);
    const float* cw = P.in[16]; const float* stc = P.in[7];
    for (int ub = blockIdx.x * 2; ub < NUNIT; ub += gridDim.x * 2) {
        int tid = threadIdx.x; asm volatile("" : "+v"(tid));
        const int tg = tid & 255, wg4 = __builtin_amdgcn_readfirstlane((tid >> 6) & 3), lane = tid & 63, r32 = lane & 31, hi = lane >> 5;
        const int u = ub + grp, sq = u >> 4, h = u & 15;
        const bool isS = sq >= 256; const int bsm = sq - 256;
        const int m0 = isS ? SEQ + 64 * bsm : 64 * sq;
        unsigned char* ublk = unit_ptr(P, u);
        if (tg < 64) {
            const int t = tg;
            const float ab = ABp[(size_t)(m0 + t) * 16 + h], bb = BBp[(size_t)(m0 + t) * 16 + h];
            const float x = ab + P.in[18][h];
            const float sp = x > 20.f ? x : log1pf(expf(x));
            float gcv = -expf(P.in[17][h]) * sp;
#pragma unroll
            for (int off = 1; off < 64; off <<= 1) { const float v = __shfl_up(gcv, off); if (lane >= off) gcv += v; }
            const float gcl = __shfl(gcv, 63);
            GC[t] = gcv; BETA[t] = 1.0f / (1.0f + expf(-bb)); EG[t] = expf(gcv); EKD[t] = expf(gcl - gcv);
            if (t == 63) GL[u] = expf(gcv);
        }
        float xr[64];
        {
            const int col = (wg4 < 2 ? 4096 + h * 128 + wg4 * 64 : 2048 + h * 128 + (wg4 - 2) * 64) + lane;
            const float w0 = cw[col], w1 = cw[CONVB + col], w2 = cw[2 * CONVB + col], w3 = cw[3 * CONVB + col];
            float xm3, xm2, xm1;
            if (isS) { const float* sp = stc + (size_t)bsm * 3 * CONVB + col; xm3 = sp[0]; xm2 = sp[CONVB]; xm1 = sp[2 * CONVB]; }
            else if (sq == 0) { xm3 = 0.f; xm2 = 0.f; xm1 = 0.f; }
            else { const bf16_t* pp = QKVB + (size_t)(m0 - 3) * CONVB + col; xm3 = bf2f(pp[0]); xm2 = bf2f(pp[CONVB]); xm1 = bf2f(pp[2 * CONVB]); }
            const bf16_t* px = QKVB + (size_t)m0 * CONVB + col;
            bf16_t xin[64];
#pragma unroll
            for (int t = 0; t < 64; ++t) xin[t] = px[(size_t)t * CONVB];
#pragma unroll
            for (int t = 0; t < 64; ++t) {
                const float x = bf2f(xin[t]);
                const float y = fmaf(w0, xm3, fmaf(w1, xm2, fmaf(w2, xm1, w3 * x)));
                xr[t] = siluf_(y);
                xm3 = xm2; xm2 = xm1; xm1 = x;
            }
            asm volatile("" ::: "memory");
            if (wg4 >= 2) {
                const int dk = (wg4 - 2) * 64 + lane;
#pragma unroll
                for (int t = 0; t < 64; ++t) *(LAS bf16_t*)(Kraw + t * 256 + ((((dk >> 3) ^ (t & 15))) << 4) + (dk & 7) * 2) = f2bf(xr[t]);
            }
        }
        {
            const int dq = tg & 127, half = tg >> 7, col = h * 128 + dq, ts = 32 * half;
            const float w0 = cw[col], w1 = cw[CONVB + col], w2 = cw[2 * CONVB + col], w3 = cw[3 * CONVB + col];
            float xm3, xm2, xm1;
            if (half == 0 && isS) { const float* sp = stc + (size_t)bsm * 3 * CONVB + col; xm3 = sp[0]; xm2 = sp[CONVB]; xm1 = sp[2 * CONVB]; }
            else if (half == 0 && sq == 0) { xm3 = 0.f; xm2 = 0.f; xm1 = 0.f; }
            else { const bf16_t* pp = QKVB + (size_t)(m0 + ts - 3) * CONVB + col; xm3 = bf2f(pp[0]); xm2 = bf2f(pp[CONVB]); xm1 = bf2f(pp[2 * CONVB]); }
            const bf16_t* px = QKVB + (size_t)(m0 + ts) * CONVB + col;
            bf16_t xin[32];
#pragma unroll
            for (int i = 0; i < 32; ++i) xin[i] = px[(size_t)i * CONVB];
#pragma unroll
            for (int i = 0; i < 32; ++i) {
                const int t = ts + i;
                const float x = bf2f(xin[i]);
                const float y = fmaf(w0, xm3, fmaf(w1, xm2, fmaf(w2, xm1, w3 * x)));
                *(LAS bf16_t*)(Qraw + t * 256 + ((((dq >> 3) ^ (t & 15))) << 4) + (dq & 7) * 2) = f2bf(siluf_(y));
                xm3 = xm2; xm2 = xm1; xm1 = x;
            }
            asm volatile("" ::: "memory");
        }
        __syncthreads();
        {
            const int row = tg >> 2, qt = tg & 3; float sk = 0.f, sq2 = 0.f;
#pragma unroll
            for (int c = 0; c < 4; ++c) {
                const int pc = ((4 * qt + c) ^ (row & 15)) << 4;
                const u32x4 a = *(const LAS u32x4*)(Kraw + row * 256 + pc), b = *(const LAS u32x4*)(Qraw + row * 256 + pc);
                const float ak[8] = {bflo(a.x), bfhi(a.x), bflo(a.y), bfhi(a.y), bflo(a.z), bfhi(a.z), bflo(a.w), bfhi(a.w)};
                const float bq[8] = {bflo(b.x), bfhi(b.x), bflo(b.y), bfhi(b.y), bflo(b.z), bfhi(b.z), bflo(b.w), bfhi(b.w)};
#pragma unroll
                for (int q = 0; q < 8; ++q) { sk += ak[q] * ak[q]; sq2 += bq[q] * bq[q]; }
            }
            sk += __shfl_xor(sk, 1); sk += __shfl_xor(sk, 2); sq2 += __shfl_xor(sq2, 1); sq2 += __shfl_xor(sq2, 2);
            if (qt == 0) { RK[row] = rsqrtf(sk + 1e-6f); RQ[row] = rsqrtf(sq2 + 1e-6f) * 0.08838834764831845f; }
        }
        __syncthreads();
        if (wg4 < 3) {
            const int ti = wg4 == 0 ? 0 : 1, tj = wg4 == 2 ? 1 : 0;
            const int ri = 32 * ti + r32, rj = 32 * tj + r32;
            f32x16 accK = {}, accQ = {};
#pragma unroll
            for (int ks = 0; ks < 8; ++ks) {
                const int ch = 2 * ks + hi;
                const bf16x8 ki = *(const LAS bf16x8*)(Kraw + ri * 256 + ((ch ^ (ri & 15)) << 4));
                const bf16x8 kj = *(const LAS bf16x8*)(Kraw + rj * 256 + ((ch ^ (rj & 15)) << 4));
                const bf16x8 qi = *(const LAS bf16x8*)(Qraw + ri * 256 + ((ch ^ (ri & 15)) << 4));
                accK = __builtin_amdgcn_mfma_f32_32x32x16_bf16(ki, kj, accK, 0, 0, 0);
                accQ = __builtin_amdgcn_mfma_f32_32x32x16_bf16(kj, qi, accQ, 0, 0, 0);
            }
            {
                const int j = rj; const float rkj = RK[j], gcj = GC[j];
#pragma unroll
                for (int r = 0; r < 16; ++r) {
                    const int i = 32 * ti + crow(r, hi);
                    const float v = i > j ? BETA[i] * RK[i] * rkj * accK[r] * __expf(fminf(GC[i] - gcj, 0.f)) : 0.f;
                    Ml[i * 64 + j] = v;
                }
            }
            {
                const int i = ri; const float rqi = RQ[i], gci = GC[i];
                unsigned char* Ab = ublk + UB_A + i * RA;
#pragma unroll
                for (int g = 0; g < 4; ++g) {
                    float v[4];
#pragma unroll
                    for (int e = 0; e < 4; ++e) { const int j = 32 * tj + 8 * g + 4 * hi + e; v[e] = i >= j ? rqi * RK[j] * accQ[4 * g + e] * __expf(fminf(gci - GC[j], 0.f)) : 0.f; }
                    u32x2 o; o.x = cvt_pk_bf16(v[0], v[1]); o.y = cvt_pk_bf16(v[2], v[3]);
                    *(u32x2*)(Ab + (4 * tj + g) * 16 + hi * 8) = o;
                }
            }
        } else {
            unsigned char* Ab = ublk + UB_A + r32 * RA;
#pragma unroll
            for (int g = 0; g < 4; ++g) { u32x2 o; o.x = 0u; o.y = 0u; *(u32x2*)(Ab + (4 + g) * 16 + hi * 8) = o; }
        }
        __syncthreads();
        if (wg4 >= 2) {
            const int dk = (wg4 - 2) * 64 + lane;
            unsigned char* kd = ublk + UB_KD + dk * RA;
#pragma unroll
            for (int c = 0; c < 8; ++c) {
                float v[8];
#pragma unroll
                for (int q = 0; q < 8; ++q) { const int t = 8 * c + q; v[q] = xr[t] * RK[t] * EKD[t]; }
                u32x4 o; o.x = cvt_pk_bf16(v[0], v[1]); o.y = cvt_pk_bf16(v[2], v[3]); o.z = cvt_pk_bf16(v[4], v[5]); o.w = cvt_pk_bf16(v[6], v[7]);
                *(u32x2*)(kd + c * 16) = u32x2{o.x, o.y}; *(u32x2*)(kd + c * 16 + 8) = u32x2{o.z, o.w};
            }
#pragma unroll
            for (int t = 0; t < 64; ++t) xr[t] *= RK[t] * BETA[t] * EG[t];
        } else {
#pragma unroll
            for (int t = 0; t < 64; ++t) xr[t] *= BETA[t];
        }
#pragma unroll
        for (int ib = 0; ib < 64; ib += 4) {
            int mi[4];
#pragma unroll
            for (int c = 0; c < 4; ++c) mi[c] = __float_as_int(Ml[(ib + c) * 64 + lane]);
#pragma unroll
            for (int c = 0; c < 4; ++c) {
                const int i = ib + c;
                float a0 = 0.f, a1 = 0.f;
#pragma unroll
                for (int j0 = 0; j0 < i; j0 += 4) {
                    float mv[4];
#pragma unroll
                    for (int k = 0; k < 4; ++k) if (j0 + k < i) mv[k] = __int_as_float(__builtin_amdgcn_readlane(mi[c], j0 + k));
#pragma unroll
                    for (int k = 0; k < 4; ++k) if (j0 + k < i) { if (k & 1) a1 = fmaf(mv[k], xr[j0 + k], a1); else a0 = fmaf(mv[k], xr[j0 + k], a0); }
                }
                if (i > 0) xr[i] -= (a0 + a1);
            }
            asm volatile("" ::: "memory");
        }
        if (wg4 < 2) {
            bf16_t* U = (bf16_t*)(ublk + UB_U) + wg4 * 64 + lane;
#pragma unroll
            for (int t = 0; t < 64; ++t) U[t * 128] = f2bf(xr[t]);
        } else {
            const int dk = (wg4 - 2) * 64 + lane;
#pragma unroll
            for (int t = 0; t < 64; ++t) *(bf16_t*)(ublk + UB_W + t * RW + dk * 2) = f2bf(xr[t]);
        }
        {
            const int row = tg >> 2, qt = tg & 3; const float s = RQ[row] * EG[row];
#pragma unroll
            for (int c = 0; c < 4; ++c) {
                const int pc = ((4 * qt + c) ^ (row & 15)) << 4;
                const u32x4 b = *(const LAS u32x4*)(Qraw + row * 256 + pc);
                u32x4 o; o.x = cvt_pk_bf16(bflo(b.x) * s, bfhi(b.x) * s); o.y = cvt_pk_bf16(bflo(b.y) * s, bfhi(b.y) * s); o.z = cvt_pk_bf16(bflo(b.z) * s, bfhi(b.z) * s); o.w = cvt_pk_bf16(bflo(b.w) * s, bfhi(b.w) * s);
                { unsigned char* qp = ublk + UB_QG + row * RW + (4 * qt + c) * 16; *(u32x2*)qp = u32x2{o.x, o.y}; *(u32x2*)(qp + 8) = u32x2{o.z, o.w}; }
            }
        }
        __syncthreads();
    }
}
__device__ __forceinline__ bf16x8 pack_acc8(const f32x16& a, int s) {
    u32x4 w; w.x = cvt_pk_bf16(a[8 * s + 0], a[8 * s + 1]); w.y = cvt_pk_bf16(a[8 * s + 2], a[8 * s + 3]); w.z = cvt_pk_bf16(a[8 * s + 4], a[8 * s + 5]); w.w = cvt_pk_bf16(a[8 * s + 6], a[8 * s + 7]);
    return *reinterpret_cast<bf16x8*>(&w);
}
template <int ROWB> __device__ __forceinline__ bf16x8 ld_afrag(const LAS unsigned char* rowp, int k0) {
    const u32x2 a = *(const LAS u32x2*)(rowp + k0 * 2);
    const u32x2 b = *(const LAS u32x2*)(rowp + k0 * 2 + 16);
    u32x4 w; w.x = a.x; w.y = a.y; w.z = b.x; w.w = b.y; return *reinterpret_cast<bf16x8*>(&w);
}
__device__ __forceinline__ void d2_task(const Params& P, LAS unsigned char* lds, int sq0, int nsteps, int h) {
    int tid_ = threadIdx.x; asm volatile("" : "+v"(tid_));
    const int tid = tid_, cw = __builtin_amdgcn_readfirstlane(tid >> 6);
    const bool isS = sq0 >= 256;
    {
        const u32x4* src = (const u32x4*)unit_ptr(P, sq0 * 16 + h);
        for (int i = tid; i < UNITB / 16; i += 512) *(LAS u32x4*)(lds + (size_t)i * 16) = src[i];
    }
    __syncthreads();
    if (cw >= 4) {
        for (int n = 0; n < nsteps; ++n) {
            if (n + 1 < nsteps) {
                const u32x4* src = (const u32x4*)unit_ptr(P, (sq0 + n + 1) * 16 + h);
                LAS unsigned char* dst = lds + ((n + 1) & 1) * UNITB;
                int lt = tid - 256; asm volatile("" : "+v"(lt));
                u32x4 pre[19];
#pragma unroll
                for (int i = 0; i < 19; ++i) pre[i] = src[min(lt + 256 * i, UNITB / 16 - 1)];
#pragma unroll
                for (int i = 0; i < 19; ++i) *(LAS u32x4*)(dst + (size_t)min(lt + 256 * i, UNITB / 16 - 1) * 16) = pre[i];
            }
            __syncthreads();
        }
        return;
    }
    const int d0 = 32 * cw;
    const float* GL = (const float*)(P.ws + WS_GL);
    bf16_t* OB = (bf16_t*)(P.ws + WS_OB);
    f32x16 S[4];
    {
        const int lane = tid & 63, r32 = lane & 31, hi = lane >> 5;
        if (isS) {
            const float* sp = P.in[8] + (((size_t)(sq0 - 256) * 16 + h) * 128 + 4 * hi) * 128 + d0 + r32;
#pragma unroll
            for (int t = 0; t < 4; ++t)
#pragma unroll
                for (int r = 0; r < 16; ++r) S[t][r] = sp[(size_t)(32 * t + (r & 3) + 8 * (r >> 2)) * 128];
        } else {
#pragma unroll
            for (int t = 0; t < 4; ++t) S[t] = f32x16{};
        }
    }
    for (int n = 0; n < nsteps; ++n) {
        const int sq = sq0 + n, u = sq * 16 + h;
        int lo = tid & 63; asm volatile("" : "+v"(lo));
        const int r32 = lo & 31, hi = lo >> 5;
        const LAS unsigned char* blk = lds + (n & 1) * UNITB;
        const LAS unsigned char* Wi = blk + UB_W + r32 * RW + 8 * hi; const LAS unsigned char* QGi = blk + UB_QG + r32 * RW + 8 * hi;
        const LAS unsigned char* Ai = blk + UB_A + r32 * RA + 8 * hi; const LAS unsigned char* KDi = blk + UB_KD + r32 * RA + 8 * hi;
        const LAS bf16_t* Ui = (const LAS bf16_t*)(blk + UB_U);
        const float gl = GL[u];
        const int m0 = sq < 256 ? 64 * sq : SEQ + 64 * (sq - 256);
        bf16x8 Sb[4][2];
#pragma unroll
        for (int t = 0; t < 4; ++t) { Sb[t][0] = pack_acc8(S[t], 0); Sb[t][1] = pack_acc8(S[t], 1); }
        f32x16 aW[2];
#pragma unroll
        for (int ct = 0; ct < 2; ++ct) {
            aW[ct] = f32x16{};
#pragma unroll
            for (int t = 0; t < 4; ++t) {
#pragma unroll
                for (int s = 0; s < 2; ++s)
                    aW[ct] = __builtin_amdgcn_mfma_f32_32x32x16_bf16(ld_afrag<RW>(Wi + 32 * ct * RW, 32 * t + 16 * s), Sb[t][s], aW[ct], 0, 0, 0);
                if (t & 1) __builtin_amdgcn_sched_barrier(0);
            }
        }
        bf16x8 Vb[2][2];
#pragma unroll
        for (int ct = 0; ct < 2; ++ct) {
#pragma unroll
            for (int r = 0; r < 16; ++r) aW[ct][r] = bf2f(Ui[(32 * ct + crow(r, hi)) * 128 + d0 + r32]) - aW[ct][r];
            Vb[ct][0] = pack_acc8(aW[ct], 0); Vb[ct][1] = pack_acc8(aW[ct], 1);
        }
#pragma unroll
        for (int co = 0; co < 2; ++co) {
            f32x16 aQ = f32x16{};
#pragma unroll
            for (int t = 0; t < 4; ++t) {
#pragma unroll
                for (int s = 0; s < 2; ++s)
                    aQ = __builtin_amdgcn_mfma_f32_32x32x16_bf16(ld_afrag<RW>(QGi + 32 * co * RW, 32 * t + 16 * s), Sb[t][s], aQ, 0, 0, 0);
                if (t & 1) __builtin_amdgcn_sched_barrier(0);
            }
#pragma unroll
            for (int ct = 0; ct <= co; ++ct)
#pragma unroll
                for (int s = 0; s < 2; ++s)
                    aQ = __builtin_amdgcn_mfma_f32_32x32x16_bf16(ld_afrag<RA>(Ai + 32 * co * RA, 32 * ct + 16 * s), Vb[ct][s], aQ, 0, 0, 0);
            {
                LAS unsigned char* ot = (LAS unsigned char*)blk + UB_U + d0 * 2 + (32 * co) * 256;
#pragma unroll
                for (int r = 0; r < 16; ++r) *(LAS bf16_t*)(ot + crow(r, hi) * 256 + r32 * 2) = f2bf(aQ[r]);
                asm volatile("" ::: "memory");
#pragma unroll
                for (int it = 0; it < 2; ++it) { const int row = it * 16 + (lo >> 2);
                    const u32x4 v = *(const LAS u32x4*)(ot + row * 256 + (lo & 3) * 16);
                    *(u32x4*)(OB + (size_t)(m0 + 32 * co + row) * DM + h * 128 + d0 + 8 * (lo & 3)) = v; }
                asm volatile("" ::: "memory");
            }
        }
#pragma unroll
        for (int t = 0; t < 4; ++t) {
#pragma unroll
            for (int r = 0; r < 16; ++r) S[t][r] *= gl;
#pragma unroll
            for (int ct = 0; ct < 2; ++ct)
#pragma unroll
                for (int s = 0; s < 2; ++s)
                    S[t] = __builtin_amdgcn_mfma_f32_32x32x16_bf16(ld_afrag<RA>(KDi + 32 * t * RA, 32 * ct + 16 * s), Vb[ct][s], S[t], 0, 0, 0);
            __builtin_amdgcn_sched_barrier(0);
        }
        __syncthreads();
    }
    {
        const int lane = tid & 63, r32 = lane & 31, hi = lane >> 5;
        const int sl = sq0 + nsteps - 1;
        float* dst = P.out + (isS ? O_DS + ((size_t)(sl - 256) * 16 + h) * 16384 : O_DP + (size_t)h * 16384);
#pragma unroll
        for (int t = 0; t < 4; ++t)
#pragma unroll
            for (int r = 0; r < 16; ++r) dst[(size_t)(32 * t + crow(r, hi)) * 128 + d0 + r32] = S[t][r];
    }
}
__device__ __forceinline__ void d2_phase(const Params& P, LAS unsigned char* lds) {
    const int G = gridDim.x, bx = blockIdx.x;
    for (int k = 0;; ++k) {
        int sq0, nst, h;
        if (G <= 16) { const int T = bx + k * G; if (T >= 528) break; if (T < 16) { sq0 = 0; nst = 256; h = T; } else { sq0 = 256 + ((T - 16) >> 4); nst = 1; h = (T - 16) & 15; } }
        else if (bx < 16) { if (k > 0) break; sq0 = 0; nst = 256; h = bx; }
        else { const int i = bx - 16 + k * (G - 16); if (i >= 512) break; sq0 = 256 + (i >> 4); nst = 1; h = i & 15; }
        d2_task(P, lds, sq0, nst, h);
    }
}
constexpr int IX_QROW = 144;
constexpr int IX_HS = 1028, IX_MS = 516;
constexpr int IX_HIST = 36864, IX_SM = IX_HIST + 16 * IX_HS * 4, IX_MASK = IX_SM + 512, IX_CAP = 512;
constexpr int IX_SCR_N32 = 392;
constexpr size_t IX_SCR = (size_t)IX_SCR_N32 * 2048, IX_SCR_A = WS_QKVB + 75497472, IX_SCR_NA = 188, IX_SCR_B = WS_END;
constexpr size_t WS_END2 = IX_SCR_B + (240 - IX_SCR_NA) * IX_SCR;
static_assert(IX_SCR_A + IX_SCR_NA * IX_SCR <= WS_Z, "key scratch overlaps z");
__device__ __forceinline__ unsigned lds_add(LAS unsigned* p, unsigned v) { return __hip_atomic_fetch_add(p, v, __ATOMIC_RELAXED, __HIP_MEMORY_SCOPE_WORKGROUP); }
__device__ __forceinline__ void lds_or(LAS unsigned* p, unsigned v) { (void)__hip_atomic_fetch_or(p, v, __ATOMIC_RELAXED, __HIP_MEMORY_SCOPE_WORKGROUP); }
__device__ __forceinline__ float relu_(float x) { return __int_as_float(max(__float_as_int(x), 0)); }
__device__ __forceinline__ unsigned ord_key(float x) { const unsigned u = __float_as_uint(x); return (u & 0x80000000u) ? ~u : (u | 0x80000000u); }

template <int PASS> __device__ __forceinline__ void ix_pass(const int kb, LAS unsigned char* lds, const bf16_t* KI, int n32, const float (&wv)[8], int w, int lane, u32x4* kcache = nullptr, const int pbeg = 0) {
    const int r32 = lane & 31, hi = lane >> 5, q = lane & 15, hp = (lane >> 4) & 1;
    LAS unsigned* hist = (LAS unsigned*)(lds + IX_HIST) + q * IX_HS;
    LAS unsigned* mst = (LAS unsigned*)(lds + IX_MASK) + q * IX_MS;
    LAS unsigned long long* cand = (LAS unsigned long long*)(lds + IX_HIST) + q * IX_CAP;
    const int sh = 32 - kb;
    LAS unsigned* sm = (LAS unsigned*)(lds + IX_SM);
    const unsigned prefix = sm[q]; const unsigned rem = sm[16 + q];
    const int np = n32 >> 1;
    bf16x8 A0[4], A1[4];
    if (pbeg + w < np) {
        const bf16_t* kp = KI + (size_t)(64 * (pbeg + w) + r32) * 64 + 8 * hi;
#pragma unroll
        for (int kk = 0; kk < 4; ++kk) { A0[kk] = *(const bf16x8*)(kp + 16 * kk); A1[kk] = *(const bf16x8*)(kp + 32 * 64 + 16 * kk); }
    }
    for (int pi = pbeg + w; pi < np; pi += 8) {
        bf16x8 N0[4], N1[4];
        {
            const int pn = pi + 8 < np ? pi + 8 : pi;
            const bf16_t* kp = KI + (size_t)(64 * pn + r32) * 64 + 8 * hi;
#pragma unroll
            for (int kk = 0; kk < 4; ++kk) { N0[kk] = *(const bf16x8*)(kp + 16 * kk); N1[kk] = *(const bf16x8*)(kp + 32 * 64 + 16 * kk); }
        }
        f32x16 S0 = {}, S1 = {};
        f32x16 a0 = {}, a1 = {};
        bf16x8 Bq[2][4];
#pragma unroll
        for (int kk = 0; kk < 4; ++kk) Bq[0][kk] = *(const LAS bf16x8*)(lds + (hp * 16 + q) * IX_QROW + (2 * kk + hi) * 16);
#pragma unroll
        for (int kk = 0; kk < 4; ++kk) Bq[1][kk] = *(const LAS bf16x8*)(lds + ((2 + hp) * 16 + q) * IX_QROW + (2 * kk + hi) * 16);
#pragma unroll
        for (int kk = 0; kk < 4; ++kk) {
            a0 = __builtin_amdgcn_mfma_f32_32x32x16_bf16(A0[kk], Bq[0][kk], a0, 0, 0, 0);
            a1 = __builtin_amdgcn_mfma_f32_32x32x16_bf16(A1[kk], Bq[0][kk], a1, 0, 0, 0);
        }
#pragma unroll
        for (int hh = 0; hh < 8; ++hh) {
            f32x16 n0 = {}, n1 = {};
            if (hh < 7) {
#pragma unroll
                for (int kk = 0; kk < 4; ++kk) {
                    n0 = __builtin_amdgcn_mfma_f32_32x32x16_bf16(A0[kk], Bq[(hh + 1) & 1][kk], n0, 0, 0, 0);
                    n1 = __builtin_amdgcn_mfma_f32_32x32x16_bf16(A1[kk], Bq[(hh + 1) & 1][kk], n1, 0, 0, 0);
                }
            }
            if (hh < 6) {
#pragma unroll
                for (int kk = 0; kk < 4; ++kk) Bq[hh & 1][kk] = *(const LAS bf16x8*)(lds + ((2 * (hh + 2) + hp) * 16 + q) * IX_QROW + (2 * kk + hi) * 16);
            }
#pragma unroll
            for (int r = 0; r < 16; r += 2) {
                const f32x2 w2 = {wv[hh], wv[hh]};
                const f32x2 m0 = {relu_(a0[r]), relu_(a0[r + 1])}, m1 = {relu_(a1[r]), relu_(a1[r + 1])};
                const f32x2 t0 = __builtin_elementwise_fma(m0, w2, (f32x2){S0[r], S0[r + 1]}), t1 = __builtin_elementwise_fma(m1, w2, (f32x2){S1[r], S1[r + 1]});
                S0[r] = t0[0]; S0[r + 1] = t0[1]; S1[r] = t1[0]; S1[r + 1] = t1[1];
            }
            if (hh < 7) {
#pragma unroll
                for (int g = 0; g < 8; ++g) { __builtin_amdgcn_sched_group_barrier(0x008, 1, 0); __builtin_amdgcn_sched_group_barrier(0x002, 6, 0); }
            }
#pragma unroll
            for (int r = 0; r < 16; ++r) { asm volatile("" : "+v"(S0[r])); asm volatile("" : "+v"(S1[r])); }
            a0 = n0; a1 = n1;
        }
        unsigned bits0 = 0u, bits1 = 0u; u32x4 kq0 = {0u, 0u, 0u, 0u}, kq1 = {0u, 0u, 0u, 0u};
#pragma unroll
        for (int r = 0; r < 8; ++r) {
            const auto x0 = __builtin_amdgcn_permlane16_swap(__float_as_uint(S0[r]), __float_as_uint(S0[8 + r]), false, false);
            const auto x1 = __builtin_amdgcn_permlane16_swap(__float_as_uint(S1[r]), __float_as_uint(S1[8 + r]), false, false);
            const float s0 = __uint_as_float(x0[0]) + __uint_as_float(x0[1]), s1 = __uint_as_float(x1[0]) + __uint_as_float(x1[1]);
            const unsigned k0 = ord_key(s0), k1 = ord_key(s1);
            const int rowbit = (r & 3) + 8 * (r >> 2) + 16 * hp + 4 * hi;
            if (PASS == 0 && kcache && pi < IX_SCR_N32 / 2) { kq0[r & 3] = k0; kq1[r & 3] = k1;
                if ((r & 3) == 3) { kcache[((size_t)pi * 4 + (r >> 2)) * 64 + lane] = kq0; kcache[((size_t)pi * 4 + 2 + (r >> 2)) * 64 + lane] = kq1; } }
            if (PASS == 0) {
                const unsigned b0 = k0 >> 21, b1 = k1 >> 21;
                lds_add(&hist[b0 >> 1], 1u << (16 * (b0 & 1))); lds_add(&hist[b1 >> 1], 1u << (16 * (b1 & 1)));
            } else if (PASS == 1) {
                const unsigned b0 = (k0 >> 10) & 2047u, b1 = (k1 >> 10) & 2047u;
                if ((k0 >> 21) == prefix) lds_add(&hist[b0 >> 1], 1u << (16 * (b0 & 1)));
                if ((k1 >> 21) == prefix) lds_add(&hist[b1 >> 1], 1u << (16 * (b1 & 1)));
            } else if (PASS == 2) {
                const unsigned b0 = k0 & 1023u, b1 = k1 & 1023u;
                if ((k0 >> 10) == prefix) lds_add(&hist[b0 >> 1], 1u << (16 * (b0 & 1)));
                if ((k1 >> 10) == prefix) lds_add(&hist[b1 >> 1], 1u << (16 * (b1 & 1)));
            } else {
                const unsigned h0 = kb == 32 ? k0 : (k0 >> sh), h1 = kb == 32 ? k1 : (k1 >> sh);
                bool sel0 = h0 > prefix, sel1 = h1 > prefix;
                if (kb == 32) {
                    if (h0 == prefix) sel0 = lds_add(&sm[32 + q], 1u) < rem;
                    if (h1 == prefix) sel1 = lds_add(&sm[32 + q], 1u) < rem;
                } else {
                    if (h0 == prefix) { const unsigned sl = lds_add(&sm[64 + q], 1u); if (sl < (unsigned)IX_CAP) cand[sl] = ((unsigned long long)k0 << 16) | (unsigned)(0xffff - (64 * pi + rowbit)); }
                    if (h1 == prefix) { const unsigned sl = lds_add(&sm[64 + q], 1u); if (sl < (unsigned)IX_CAP) cand[sl] = ((unsigned long long)k1 << 16) | (unsigned)(0xffff - (64 * pi + 32 + rowbit)); }
                }
                bits0 |= sel0 ? (1u << rowbit) : 0u; bits1 |= sel1 ? (1u << rowbit) : 0u;
            }
        }
        if (PASS == 3) { lds_or(&mst[2 * pi], bits0); lds_or(&mst[2 * pi + 1], bits1); }
#pragma unroll
        for (int kk = 0; kk < 4; ++kk) { A0[kk] = N0[kk]; A1[kk] = N1[kk]; }
    }
}
__device__ __forceinline__ void ix_pass_cached(const int kb, LAS unsigned char* lds, int n32, int w, int lane, const u32x4* kcache) {
    const int hi = lane >> 5, q = lane & 15, hp = (lane >> 4) & 1;
    LAS unsigned* mst = (LAS unsigned*)(lds + IX_MASK) + q * IX_MS;
    LAS unsigned long long* cand = (LAS unsigned long long*)(lds + IX_HIST) + q * IX_CAP;
    const int sh = 32 - kb;
    LAS unsigned* sm = (LAS unsigned*)(lds + IX_SM);
    const unsigned prefix = sm[q]; const unsigned rem = sm[16 + q];
    const int np = min(n32, IX_SCR_N32) >> 1;
    const u32x4* kc = kcache + lane;
    u32x4 c0[4], c1[4];
    { const int p0 = w < np ? w : 0, p1 = w + 8 < np ? w + 8 : p0;
#pragma unroll
      for (int j = 0; j < 4; ++j) { c0[j] = kc[((size_t)p0 * 4 + j) * 64]; c1[j] = kc[((size_t)p1 * 4 + j) * 64]; } }
    for (int pi = w; pi < np; pi += 8) {
        u32x4 c2[4];
        { const int pn = pi + 16 < np ? pi + 16 : pi;
#pragma unroll
          for (int j = 0; j < 4; ++j) c2[j] = kc[((size_t)pn * 4 + j) * 64]; }
        unsigned bits0 = 0u, bits1 = 0u;
#pragma unroll
        for (int r = 0; r < 8; ++r) {
            const unsigned k0 = c0[r >> 2][r & 3], k1 = c0[2 + (r >> 2)][r & 3];
            const int rowbit = (r & 3) + 8 * (r >> 2) + 16 * hp + 4 * hi;
            const unsigned h0 = kb == 32 ? k0 : (k0 >> sh), h1 = kb == 32 ? k1 : (k1 >> sh);
            bool sel0 = h0 > prefix, sel1 = h1 > prefix;
            if (kb == 32) {
                if (h0 == prefix) sel0 = lds_add(&sm[32 + q], 1u) < rem;
                if (h1 == prefix) sel1 = lds_add(&sm[32 + q], 1u) < rem;
            } else {
                if (h0 == prefix) { const unsigned sl = lds_add(&sm[64 + q], 1u); if (sl < (unsigned)IX_CAP) cand[sl] = ((unsigned long long)k0 << 16) | (unsigned)(0xffff - (64 * pi + rowbit)); }
                if (h1 == prefix) { const unsigned sl = lds_add(&sm[64 + q], 1u); if (sl < (unsigned)IX_CAP) cand[sl] = ((unsigned long long)k1 << 16) | (unsigned)(0xffff - (64 * pi + 32 + rowbit)); }
            }
            bits0 |= sel0 ? (1u << rowbit) : 0u; bits1 |= sel1 ? (1u << rowbit) : 0u;
        }
        lds_or(&mst[2 * pi], bits0); lds_or(&mst[2 * pi + 1], bits1);
#pragma unroll
        for (int j = 0; j < 4; ++j) { c0[j] = c1[j]; c1[j] = c2[j]; }
    }
}
__device__ __forceinline__ void ix_select(const int NBITS, LAS unsigned char* lds, int w, int lane) {
    const int WPL = (1 << NBITS) / 128;
    LAS unsigned* sm = (LAS unsigned*)(lds + IX_SM);
#pragma unroll 1
    for (int qq = 0; qq < 2; ++qq) {
        const int q = 2 * w + qq;
        LAS unsigned* hist = (LAS unsigned*)(lds + IX_HIST) + q * IX_HS + lane * WPL;
        unsigned ls = 0;
#pragma unroll 1
        for (int i = 0; i < WPL; ++i) { const unsigned v = hist[i]; ls += (v & 0xffffu) + (v >> 16); }
        unsigned suf = ls;
#pragma unroll
        for (int off = 1; off < 64; off <<= 1) { const unsigned v = __shfl_down(suf, off); if (lane + off < 64) suf += v; }
        const unsigned rem = sm[16 + q]; const unsigned above = suf - ls;
        if (above < rem && rem <= suf) {
            unsigned c = above; int d = 0; unsigned nrem = rem, nbin = 0;
            bool found = false;
#pragma unroll 1
            for (int i = WPL - 1; i >= 0 && !found; --i) {
                const unsigned v = hist[i]; const unsigned chi = v >> 16, clo = v & 0xffffu;
                if (c + chi >= rem) { d = (lane * WPL + i) * 2 + 1; nrem = rem - c; nbin = chi; found = true; }
                else { c += chi; if (c + clo >= rem) { d = (lane * WPL + i) * 2; nrem = rem - c; nbin = clo; found = true; } else c += clo; }
            }
            sm[q] = (sm[q] << NBITS) | (unsigned)d; sm[16 + q] = nrem; sm[48 + q] = nbin;
        }
    }
}
__device__ __forceinline__ void ix_unit(const Params& P, LAS unsigned char* lds, bool isS, int idx, u32x4* kscr) {
    int tid_ = threadIdx.x; asm volatile("" : "+v"(tid_));
    const int tid = tid_, w = __builtin_amdgcn_readfirstlane(tid >> 6), lane = tid & 63;
    int m0, n32, nwords, mstride; const bf16_t* KI; unsigned* MK;
    if (!isS) { m0 = idx * 16; n32 = 2 * ((idx >> 2) + 1); nwords = 8 * ((idx >> 4) + 1); mstride = 512; KI = (const bf16_t*)(P.ws + WS_KIP); MK = (unsigned*)(P.ws + WS_MASKP) + (size_t)m0 * 512; }
    else { const int b = idx >> 2; m0 = SEQ + idx * 16; n32 = 34; nwords = 36; mstride = 36; KI = (const bf16_t*)(P.ws + WS_KIS) + (size_t)b * LS * 64; MK = (unsigned*)(P.ws + WS_MASKS) + (size_t)(idx * 16) * 36; }
    if (n32 <= 8) {
        for (int i = tid; i < 16 * nwords; i += NTHREADS) { const int q = i / nwords, wd = i % nwords; MK[(size_t)q * mstride + wd] = wd < n32 ? 0xffffffffu : 0u; }
        return;
    }
    __syncthreads();
    {
        const bf16_t* QI = (const bf16_t*)(P.ws + WS_QI) + (size_t)m0 * 1024;
#pragma unroll
        for (int i = 0; i < 4; ++i) {
            const int cid = tid + 512 * i, q = cid >> 7, hc = cid & 127, h = hc >> 3, ch = hc & 7;
            *(LAS u32x4*)(lds + (h * 16 + q) * IX_QROW + ch * 16) = *(const u32x4*)(QI + (size_t)q * 1024 + h * 64 + ch * 8);
        }
    }
    u32x4* kc = kscr;
    float wv[8];
    {
        const float* WI = (const float*)(P.ws + WS_WI) + (size_t)(m0 + (lane & 15)) * 16 + ((lane >> 4) & 1);
#pragma unroll
        for (int hh = 0; hh < 8; ++hh) wv[hh] = WI[2 * hh];
    }
    LAS unsigned* sm = (LAS unsigned*)(lds + IX_SM);
    if (tid < 16) { sm[tid] = 0u; sm[16 + tid] = 256u; sm[32 + tid] = 0u; sm[48 + tid] = 0u; sm[64 + tid] = 0u; }
    int kb = 0;
#pragma unroll 1
    for (int level = 0; level < 3; ++level) {
        for (int i = tid; i < 16 * IX_HS / 4; i += NTHREADS) *(LAS u32x4*)(lds + IX_HIST + (size_t)i * 16) = u32x4{0u, 0u, 0u, 0u};
        __syncthreads();
        if (level == 0) ix_pass<0>(0, lds, KI, n32, wv, w, lane, kc); else if (level == 1) ix_pass<1>(0, lds, KI, n32, wv, w, lane); else ix_pass<2>(0, lds, KI, n32, wv, w, lane);
        __syncthreads();
        ix_select(level == 2 ? 10 : 11, lds, w, lane);
        kb += level == 2 ? 10 : 11;
        __syncthreads();
        if (!__any(sm[48 + (lane & 15)] > (unsigned)IX_CAP)) break;
    }
    for (int i = tid; i < 16 * IX_MS / 4; i += NTHREADS) *(LAS u32x4*)(lds + IX_MASK + (size_t)i * 16) = u32x4{0u, 0u, 0u, 0u};
    __syncthreads();
    if (kc) { ix_pass_cached(kb, lds, n32, w, lane, kc); if (n32 > IX_SCR_N32) ix_pass<3>(kb, lds, KI, n32, wv, w, lane, nullptr, IX_SCR_N32 / 2); }
    else ix_pass<3>(kb, lds, KI, n32, wv, w, lane);
    __syncthreads();
#ifdef PROBE_PF
    for (int i = tid; i < 16 * IX_MS / 4; i += NTHREADS) *(LAS u32x4*)(lds + IX_MASK + (size_t)i * 16) = u32x4{0u, 0u, 0u, 0u};
    if (tid < 16) { sm[32 + tid] = 0u; sm[64 + tid] = 0u; }
    __syncthreads();
    ix_pass<3>(kb, lds, KI, n32, wv, w, lane);
    __syncthreads();
#endif
    if (kb < 32) {
#pragma unroll 1
        for (int qq = 0; qq < 2; ++qq) {
            const int q = 2 * w + qq;
            const LAS unsigned long long* cand = (const LAS unsigned long long*)(lds + IX_HIST) + q * IX_CAP;
            LAS unsigned* mst = (LAS unsigned*)(lds + IX_MASK) + q * IX_MS;
            const int n = (int)min(sm[64 + q], (unsigned)IX_CAP); const unsigned rem = sm[16 + q];
            const int nk = (n + 63) >> 6;
            unsigned long long own[8]; unsigned cnt[8];
#pragma unroll
            for (int k = 0; k < 8; ++k) { const int i = lane + 64 * k; own[k] = i < n ? cand[i] : ~0ull; cnt[k] = 0u; }
#pragma unroll 4
            for (int j = 0; j < n; j += 2) {
                typedef unsigned long long u64x2 __attribute__((ext_vector_type(2)));
                const u64x2 x = *(const LAS u64x2*)(cand + j);
                const unsigned long long x0 = x[0], x1 = j + 1 < n ? x[1] : 0ull;
#pragma unroll
                for (int k = 0; k < 8; ++k) if (k < nk) cnt[k] += (x0 > own[k] ? 1u : 0u) + (x1 > own[k] ? 1u : 0u);
            }
#pragma unroll
            for (int k = 0; k < 8; ++k) if (lane + 64 * k < n && cnt[k] < rem) { const unsigned kx = 0xffffu - (unsigned)(own[k] & 0xffffu); lds_or(&mst[kx >> 5], 1u << (kx & 31)); }
        }
    }
    __syncthreads();
    for (int i = tid; i < 16 * nwords; i += NTHREADS) { const int q = i / nwords, wd = i % nwords; MK[(size_t)q * mstride + wd] = ((const LAS unsigned*)(lds + IX_MASK))[q * IX_MS + wd]; }
}
#ifndef IX_NS_SCAN
#define IX_NS_SCAN 0
#endif
__device__ __forceinline__ void indexer_phase(const Params& P, LAS unsigned char* lds) {
    const bool shared = gridDim.x > 32;
    const int G = shared ? (int)gridDim.x - 16 : (int)gridDim.x, bx = shared ? (int)blockIdx.x - 16 : (int)blockIdx.x;
    if (bx < 0) {
        if (shared) for (int i = (int)blockIdx.x; i < IX_NS_SCAN; i += 16) ix_unit(P, lds, true, i, nullptr);
        return;
    }
    const int ns0 = shared ? IX_NS_SCAN : 0;
    u32x4* kscr = (P.ph_hi && shared && G == 240) ? (u32x4*)(P.ws + (bx < (int)IX_SCR_NA ? IX_SCR_A + (size_t)bx * IX_SCR : IX_SCR_B + (size_t)(bx - (int)IX_SCR_NA) * IX_SCR)) : nullptr;
    const int rp = (1024 + G - 1) / G, rs = (128 + G - 1) / G;
#pragma unroll 1
    for (int r = 0; r < rp + rs; ++r) {
        bool isS; int idx;
        if (r < rp) { const int qt = ((r & 1) || r == rp - 1) ? r * G + (G - 1 - bx) : r * G + bx; if (qt >= 1024) continue; isS = false; idx = 1023 - qt; }
        else { const int i = ns0 + (r - rp) * G + bx; if (i >= 128) continue; isS = true; idx = i; }
        ix_unit(P, lds, isS, idx, kscr);
    }
}
namespace att {
constexpr int D = 128, QBLK = 32, KVBLK = 64;
constexpr float SCALE = 0.088388347648318440f;
constexpr float THR = 8.f;
constexpr size_t SHM_V = KVBLK * D * 2, SHM_K = KVBLK * D * 2, SHM_ATTN = 2 * SHM_V + 2 * SHM_K + 8 * 64 * 4;
constexpr int QL_OFF = (int)SHM_ATTN, LUT_OFF = QL_OFF + 8 * 32 * 256;
using f32x8 = __attribute__((ext_vector_type(8))) float;
#define KSWZ(row, colB) ((row) * 256 + ((colB) ^ (((row) & 7) << 4)))
#define SBAR() __builtin_amdgcn_sched_barrier(0)
template <typename TIn> struct Stage;
template <> struct Stage<bf16_t> { using T = bf16x8;
  __device__ static __forceinline__ T ld8(const bf16_t* p) { return *reinterpret_cast<const bf16x8*>(p); }
  __device__ static __forceinline__ bf16x8 tobf(T x) { return x; } };
template <> struct Stage<float> { using T = f32x8;
  __device__ static __forceinline__ T ld8(const float* p) { return *reinterpret_cast<const f32x8*>(p); }
  __device__ static __forceinline__ bf16x8 tobf(T x) {
    u32x4 w = {cvt_pk_bf16(x[0], x[1]), cvt_pk_bf16(x[2], x[3]), cvt_pk_bf16(x[4], x[5]), cvt_pk_bf16(x[6], x[7])}; return *reinterpret_cast<bf16x8*>(&w); } };

__device__ __forceinline__ void partialSM(f32x16& p0, f32x16& p1, float& m_reg, float& mn, float& alpha, const float bC) {
  constexpr float C = SCALE * 1.4426950408889634f;
  float pmax = p0[0]; for (int r = 1; r < 16; ++r) pmax = fmaxf(pmax, p0[r]); for (int r = 0; r < 16; ++r) pmax = fmaxf(pmax, p1[r]);
  { auto rr = __builtin_amdgcn_permlane32_swap(__float_as_uint(pmax), __float_as_uint(pmax), false, false);
    pmax = fmaxf(__uint_as_float(rr[0]), __uint_as_float(rr[1])); }
  if (__builtin_expect(__all(pmax - m_reg <= THR / SCALE), 1)) { mn = m_reg; alpha = 1.f; }
  else { mn = fmaxf(m_reg, pmax); alpha = __builtin_amdgcn_exp2f((m_reg - mn) * C); m_reg = mn; }
  float mnC = -mn * C + bC;
  for (int r = 0; r < 16; ++r) p0[r] = fmaf(p0[r], C, mnC); for (int r = 0; r < 16; ++r) p1[r] = fmaf(p1[r], C, mnC);
  for (int r = 0; r < 16; ++r) p0[r] = __builtin_amdgcn_exp2f(p0[r]);
}
__device__ __forceinline__ void finishSM(f32x16& p0, f32x16& p1, float alpha, float& l_reg, bf16x8& pa0, bf16x8& pa1, bf16x8& pa2, bf16x8& pa3) {
  for (int r = 0; r < 16; ++r) p1[r] = __builtin_amdgcn_exp2f(p1[r]);
  float ps = 0; for (int r = 0; r < 16; ++r) ps += p0[r]; for (int r = 0; r < 16; ++r) ps += p1[r];
  { auto rr = __builtin_amdgcn_permlane32_swap(__float_as_uint(ps), __float_as_uint(ps), false, false);
    ps = __uint_as_float(rr[0]) + __uint_as_float(rr[1]); }
  l_reg = l_reg * alpha + ps;
#define PK4(P, BASE, OUT) do { unsigned a0 = cvt_pk_bf16(P[BASE + 0], P[BASE + 1]), a1 = cvt_pk_bf16(P[BASE + 2], P[BASE + 3]);   \
    unsigned b0 = cvt_pk_bf16(P[BASE + 4], P[BASE + 5]), b1 = cvt_pk_bf16(P[BASE + 6], P[BASE + 7]);                              \
    auto r0 = __builtin_amdgcn_permlane32_swap(a0, b0, false, false); auto r1 = __builtin_amdgcn_permlane32_swap(a1, b1, false, false); \
    u32x4 w = {r0[0], r1[0], r0[1], r1[1]}; OUT = *reinterpret_cast<bf16x8*>(&w); } while (0)
  PK4(p0, 0, pa0); PK4(p0, 8, pa1); PK4(p1, 0, pa2); PK4(p1, 8, pa3);
#undef PK4
}
__device__ __forceinline__ void qkt(f32x16& p0, f32x16& p1, const LAS char* Ks, const LAS char* Qs, int r32, int hi) {
  p0 = f32x16{}; p1 = f32x16{};
  bf16x8 b0[2], b1[2], qf[2];
  { const int cb = (hi * 8) * 2;
    b0[0] = *reinterpret_cast<const LAS bf16x8*>(Ks + KSWZ(r32, cb)); b1[0] = *reinterpret_cast<const LAS bf16x8*>(Ks + KSWZ(32 + r32, cb)); qf[0] = *reinterpret_cast<const LAS bf16x8*>(Qs + KSWZ(r32, cb)); }
  __builtin_amdgcn_sched_group_barrier(0x100, 3, 0);
#pragma unroll
  for (int d0 = 0; d0 < 8; ++d0) {
    if (d0 < 7) { const int cb = ((d0 + 1) * 16 + hi * 8) * 2;
      b0[(d0 + 1) & 1] = *reinterpret_cast<const LAS bf16x8*>(Ks + KSWZ(r32, cb)); b1[(d0 + 1) & 1] = *reinterpret_cast<const LAS bf16x8*>(Ks + KSWZ(32 + r32, cb));
      qf[(d0 + 1) & 1] = *reinterpret_cast<const LAS bf16x8*>(Qs + KSWZ(r32, cb));
      __builtin_amdgcn_sched_group_barrier(0x100, 3, 0); }
    p0 = __builtin_amdgcn_mfma_f32_32x32x16_bf16(b0[d0 & 1], qf[d0 & 1], p0, 0, 0, 0);
    p1 = __builtin_amdgcn_mfma_f32_32x32x16_bf16(b1[d0 & 1], qf[d0 & 1], p1, 0, 0, 0);
    __builtin_amdgcn_sched_group_barrier(0x008, 2, 0); }
}
__device__ __forceinline__ int v_st(int k, int c) { const int kk = (k & ~0xC) | ((k & 4) << 1) | ((k & 8) >> 1); return ((kk >> 3) * 4 + (c >> 5)) * 512 + ((kk & 7) * 32 + (c & 31)) * 2; }
__device__ __forceinline__ int v_rd_base(int lane) { return ((lane & 3) << 3) | (((lane >> 2) & 3) << 6) | (((lane >> 4) & 1) << 5) | (((lane >> 5) & 1) << 8); }
constexpr int v_rd_off(int d0, int ks, int half) { return d0 * 512 + ks * 4096 + half * 2048; }
template <int OFF> __device__ __forceinline__ s16x4 tr_read(int vb) {
  s16x4 r; asm volatile("ds_read_b64_tr_b16 %0, %1 offset:%2" : "=&v"(r) : "v"(vb), "i"(OFF) : "memory"); return r;
}
template <int D0> __device__ __forceinline__ void pv_one(f32x16& od, int vb, bf16x8 pa0, bf16x8 pa1, bf16x8 pa2, bf16x8 pa3) {
  const s16x4 l0 = tr_read<v_rd_off(D0, 0, 0)>(vb), h0 = tr_read<v_rd_off(D0, 0, 1)>(vb), l1 = tr_read<v_rd_off(D0, 1, 0)>(vb), h1 = tr_read<v_rd_off(D0, 1, 1)>(vb);
  const s16x4 l2 = tr_read<v_rd_off(D0, 2, 0)>(vb), h2 = tr_read<v_rd_off(D0, 2, 1)>(vb), l3 = tr_read<v_rd_off(D0, 3, 0)>(vb), h3 = tr_read<v_rd_off(D0, 3, 1)>(vb);
  asm volatile("s_waitcnt lgkmcnt(0)" ::: "memory"); SBAR();
#define PK(L, H) (bf16x8){L[0], L[1], L[2], L[3], H[0], H[1], H[2], H[3]}
  od = __builtin_amdgcn_mfma_f32_32x32x16_bf16(pa0, PK(l0, h0), od, 0, 0, 0);
  od = __builtin_amdgcn_mfma_f32_32x32x16_bf16(pa1, PK(l1, h1), od, 0, 0, 0);
  od = __builtin_amdgcn_mfma_f32_32x32x16_bf16(pa2, PK(l2, h2), od, 0, 0, 0);
  od = __builtin_amdgcn_mfma_f32_32x32x16_bf16(pa3, PK(l3, h3), od, 0, 0, 0);
#undef PK
}
__device__ __forceinline__ void pv_d0(f32x16* o, int vb, bf16x8 pa0, bf16x8 pa1, bf16x8 pa2, bf16x8 pa3) {
  pv_one<0>(o[0], vb, pa0, pa1, pa2, pa3); pv_one<1>(o[1], vb, pa0, pa1, pa2, pa3); pv_one<2>(o[2], vb, pa0, pa1, pa2, pa3); pv_one<3>(o[3], vb, pa0, pa1, pa2, pa3);
}
__device__ __forceinline__ void mask_bias(f32x16& p0, f32x16& p1, unsigned long long mw, int hi, bool far, float cfar, const LAS float* lut, int relb) {
  const unsigned lo = (unsigned)mw >> (4 * hi), hw = (unsigned)(mw >> 32) >> (4 * hi);
  const float ninf = -__builtin_inff();
  if (far) {
#pragma unroll
    for (int r = 0; r < 16; ++r) { const int bit = (r & 3) + 8 * (r >> 2);
      const unsigned m0 = (unsigned)__builtin_amdgcn_sbfe((int)lo, bit, 1), m1 = (unsigned)__builtin_amdgcn_sbfe((int)hw, bit, 1);
      p0[r] = __uint_as_float((__float_as_uint(p0[r]) & m0) | (0xff800000u & ~m0)); p1[r] = __uint_as_float((__float_as_uint(p1[r]) & m1) | (0xff800000u & ~m1)); }
  } else {
    const int rb = relb + 4 * hi;
#pragma unroll
    for (int r = 0; r < 16; ++r) { const int bit = (r & 3) + 8 * (r >> 2);
      const int i0 = min(max(rb + bit, 0), 191), i1 = min(max(rb + 32 + bit, 0), 191);
      p0[r] = ((lo >> bit) & 1u) ? p0[r] + lut[i0] : ninf; p1[r] = ((hw >> bit) & 1u) ? p1[r] + lut[i1] : ninf;
      asm volatile("" : "+v"(p0[r]), "+v"(p1[r])); }
  }
}
struct KVSrc { const void* k0; const void* v0; const void* k1; const void* v1; int splitT; };

template <typename TKV, int SDEPTH>
__device__ __forceinline__ void attn_unit(const bf16_t* __restrict__ Qb, const KVSrc kv, bf16_t* __restrict__ Ob, int NT, const unsigned long long* __restrict__ maskb, int mstride,
                                          int qpos0, int nvalid, int jlbase, LAS char* lds, const int tid) {
  using St = Stage<TKV>;
  const int wid = __builtin_amdgcn_readfirstlane(tid >> 6), lane = tid & 63, r32 = lane & 31, hi = lane >> 5;
  LAS char* V_lds = lds; LAS char* K_lds = lds + 2 * SHM_V;
  LAS float* wsl = (LAS float*)(lds + 2 * SHM_V + 2 * SHM_K) + wid * 64; LAS float* li_l = wsl; LAS float* al_l = wsl + 32;
  const LAS float* lut = (const LAS float*)(lds + LUT_OFF);
  float m_reg = -1e30f, l_reg = 0; f32x16 o[4] = {};
  LAS char* qr = lds + QL_OFF + wid * 8192;
  const int wrow = (wid * QBLK < nvalid) ? wid * QBLK : (wid * QBLK) % nvalid;
  const bool wvalid = wid * QBLK < nvalid;
  const int jl = wvalid ? (jlbase < 0 ? -jlbase : jlbase + (wid >> 1) + 1) : 0;
  const bf16_t* Qw = Qb + (size_t)(wrow + r32) * DM + hi * 8;
#pragma unroll
  for (int d0 = 0; d0 < 8; ++d0) *reinterpret_cast<LAS bf16x8*>(qr + KSWZ(r32, (d0 * 16 + hi * 8) * 2)) = *reinterpret_cast<const bf16x8*>(Qw + d0 * 16);
  const unsigned moff = (unsigned)((wrow + r32) * mstride);
  const int qpos = qpos0 + wrow + r32, qposw = qpos0 + wrow;
  const float cfar = lut[0]; const float cfarC = cfar * (SCALE * 1.4426950408889634f); float bC_ = 0.f;
  const int sr = tid >> 4, sc = (tid & 15) * 8, vst0 = v_st(sr, sc), vst1 = v_st(32 + sr, sc);
  const int vb0 = (int)(uintptr_t)V_lds + v_rd_base(lane);
  const int lofs = sr * DM + sc;
  struct { typename St::T vs0, vs1, ks0, ks1; } sr_[SDEPTH];
#define SLOAD(i, k0_) do { const int jt_ = (k0_) >> 6; const bool fst_ = jt_ < kv.splitT; \
    const TKV* kb_ = (fst_ ? (const TKV*)kv.k0 + (size_t)jt_ * 64 * DM : (const TKV*)kv.k1) + lofs; const TKV* vb_ = (fst_ ? (const TKV*)kv.v0 + (size_t)jt_ * 64 * DM : (const TKV*)kv.v1) + lofs; \
    sr_[i].vs0 = St::ld8(vb_); sr_[i].vs1 = St::ld8(vb_ + 32 * DM); sr_[i].ks0 = St::ld8(kb_); sr_[i].ks1 = St::ld8(kb_ + 32 * DM); } while (0)
#define SWRITE(b, i) do { *(LAS bf16x8*)(V_lds + (b) * SHM_V + vst0) = St::tobf(sr_[i].vs0);          \
    *(LAS bf16x8*)(V_lds + (b) * SHM_V + vst1) = St::tobf(sr_[i].vs1); int kc = sc * 2;               \
    *(LAS bf16x8*)(K_lds + (b) * SHM_K + KSWZ(sr, kc)) = St::tobf(sr_[i].ks0);                       \
    *(LAS bf16x8*)(K_lds + (b) * SHM_K + KSWZ(32 + sr, kc)) = St::tobf(sr_[i].ks1); } while (0)
#define SWAIT() do { if constexpr (SDEPTH == 2) asm volatile("s_waitcnt vmcnt(4)" ::: "memory"); else asm volatile("s_waitcnt vmcnt(0)" ::: "memory"); } while (0)
#define RESC(a) do { if (__any((a) < 1.f)) { if (hi == 0) al_l[r32] = (a); asm volatile("s_waitcnt lgkmcnt(0)" ::: "memory"); \
    for (int d = 0; d < 4; ++d) for (int r = 0; r < 16; ++r) o[d][r] *= al_l[crow(r, hi)]; } } while (0)
#define MB(P0, P1, j) do { const unsigned long long mw_ = mwn; if ((j) + 1 < NT) mwn = maskb[moff + (unsigned)((j) + 1)];     \
    const bool far_ = 64 * (j) + 191 <= qposw; bC_ = far_ ? cfarC : 0.f; mask_bias(P0, P1, mw_, hi, far_, cfar, lut, 64 * (j) - qpos + 128); } while (0)
  f32x16 pA0, pA1, pB0, pB1; float mnA, mnB, alA, alB; bf16x8 pa0, pa1, pa2, pa3;
  unsigned long long mwn = maskb[moff];
  constexpr int SE = 0, SO = SDEPTH - 1;
  SLOAD(SE, 0); asm volatile("s_waitcnt vmcnt(0)" ::: "memory"); SWRITE(0, SE); __syncthreads();
  if (0 < jl) { qkt(pA0, pA1, K_lds, qr, r32, hi); MB(pA0, pA1, 0); partialSM(pA0, pA1, m_reg, mnA, alA, bC_); }
  SLOAD(SO, KVBLK); if constexpr (SDEPTH == 2) { if (2 < NT) SLOAD(SE, 2 * KVBLK); }
  SWAIT(); SWRITE(1, SO); __syncthreads();
  for (int j = 1; j + 1 < NT; j += 2) {
    SBAR(); if (j < jl) { qkt(pB0, pB1, K_lds + SHM_K, qr, r32, hi); MB(pB0, pB1, j); }
    if (j - 1 < jl) finishSM(pA0, pA1, alA, l_reg, pa0, pa1, pa2, pa3); SBAR();
    SLOAD(SO, (j + SDEPTH) * KVBLK); SBAR();
    if (j - 1 < jl) pv_d0(o, vb0, pa0, pa1, pa2, pa3); if (j < jl) partialSM(pB0, pB1, m_reg, mnB, alB, bC_);
    __syncthreads(); SWAIT(); SWRITE(0, SE);
    if (j < jl) RESC(alB); __syncthreads();
    SBAR(); if (j + 1 < jl) { qkt(pA0, pA1, K_lds, qr, r32, hi); MB(pA0, pA1, j + 1); }
    if (j < jl) finishSM(pB0, pB1, alB, l_reg, pa0, pa1, pa2, pa3); SBAR();
    if (SDEPTH == 1 || j + 3 < NT) SLOAD(SE, (j + 1 + SDEPTH) * KVBLK); SBAR();
    if (j < jl) pv_d0(o, vb0 + (int)SHM_V, pa0, pa1, pa2, pa3); if (j + 1 < jl) partialSM(pA0, pA1, m_reg, mnA, alA, bC_);
    __syncthreads(); SWAIT(); SWRITE(1, SO);
    if (j + 1 < jl) RESC(alA); __syncthreads();
  }
  SBAR(); if (NT - 1 < jl) { qkt(pB0, pB1, K_lds + SHM_K, qr, r32, hi); MB(pB0, pB1, NT - 1); }
  if (NT - 2 < jl) finishSM(pA0, pA1, alA, l_reg, pa0, pa1, pa2, pa3); SBAR();
  if (NT - 2 < jl) pv_d0(o, vb0, pa0, pa1, pa2, pa3); if (NT - 1 < jl) partialSM(pB0, pB1, m_reg, mnB, alB, bC_);
  __syncthreads();
  if (NT - 1 < jl) { RESC(alB); finishSM(pB0, pB1, alB, l_reg, pa0, pa1, pa2, pa3); SBAR();
    pv_d0(o, vb0 + (int)SHM_V, pa0, pa1, pa2, pa3); }
  if (hi == 0) li_l[r32] = l_reg; asm volatile("s_waitcnt lgkmcnt(0)" ::: "memory");
  float rli[16];
#pragma unroll
  for (int r = 0; r < 16; ++r) rli[r] = __builtin_amdgcn_rcpf(li_l[crow(r, hi)]);
  if (wvalid) {
    int lo_ = lane; asm volatile("" : "+v"(lo_));
    const int r32o = lo_ & 31, hio = lo_ >> 5;
    LAS char* ot = qr;
#pragma unroll
    for (int r = 0; r < 16; ++r) { const int orow = crow(r, hio);
#pragma unroll
      for (int d0 = 0; d0 < 4; ++d0) { const int dv = d0 * 32 + r32o;
        *(LAS bf16_t*)(ot + orow * 256 + ((((dv >> 3) ^ (orow & 7)) << 4) | ((dv & 7) << 1))) = f2bf(o[d0][r] * rli[r]); } }
    asm volatile("" ::: "memory");
    const int ch = lo_ & 15, rq = lo_ >> 4;
    bf16_t* Ow = Ob + (size_t)(wid * QBLK) * DM + ch * 8;
#pragma unroll
    for (int it = 0; it < 8; ++it) { const int row = it * 4 + rq;
      const u32x4 v = *(const LAS u32x4*)(ot + row * 256 + ((ch ^ (row & 7)) << 4));
      *(u32x4*)(Ow + (size_t)row * DM) = v; }
  }
  __syncthreads();
#undef SLOAD
#undef SWRITE
#undef SWAIT
#undef RESC
#undef MB
}
#undef KSWZ
#undef SBAR
}

__device__ __forceinline__ int t5_bucket(int rel) {
    const int n = rel < 0 ? -rel : rel;
    const int lg = n < 8 ? n : (n < 12 ? 8 : (n < 16 ? 9 : (n < 23 ? 10 : (n < 32 ? 11 : (n < 46 ? 12 : (n < 64 ? 13 : (n < 91 ? 14 : 15)))))));
    return (rel > 0 ? 16 : 0) + lg;
}
__device__ __forceinline__ void attn_phase(const Params& P, LAS unsigned char* lds) {
    const int G = gridDim.x, bx = blockIdx.x;
    bf16_t* Q = (bf16_t*)(P.ws + WS_Q); bf16_t* O = (bf16_t*)(P.ws + WS_H);
    LAS float* lut = (LAS float*)(lds + att::LUT_OFF);
#pragma unroll 1
    for (int r = 0; r * G < 1024; ++r) {
        const int t = (r & 1) ? r * G + (G - 1 - bx) : r * G + bx; if (t >= 1024) continue;
        const int idx = 1023 - t, h = idx & 15, blk = idx >> 4;
        int tid = threadIdx.x; asm volatile("" : "+v"(tid));
        __syncthreads();
        if (tid < 192) lut[tid] = P.in[10][t5_bucket(tid - 128) * 16 + h] * (1.0f / att::SCALE);
        __syncthreads();
        att::KVSrc kv{(const bf16_t*)(P.ws + WS_KP) + h * 128, (const bf16_t*)(P.ws + WS_VP) + h * 128, nullptr, nullptr, 1 << 30};
        att::attn_unit<bf16_t, 1>(Q + (size_t)(256 * blk) * DM + h * 128, kv, O + (size_t)(256 * blk) * DM + h * 128, 4 * (blk + 1),
                                  (const unsigned long long*)(P.ws + WS_MASKP) + (size_t)(256 * blk) * 256, 256, 256 * blk, 256, 4 * blk, (LAS char*)lds, tid);
    }
#pragma unroll 1
    for (int i = bx; i < 512; i += G) {
        const int h = i & 15, blk = i >> 4;
        int tid = threadIdx.x; asm volatile("" : "+v"(tid));
        __syncthreads();
        if (tid < 192) lut[tid] = P.in[10][t5_bucket(tid - 128) * 16 + h] * (1.0f / att::SCALE);
        __syncthreads();
        att::KVSrc kv{P.in[4] + (size_t)blk * PAST * DM + h * 128, P.in[5] + (size_t)blk * PAST * DM + h * 128,
                      P.out + O_KS + (size_t)blk * TS * DM + h * 128, P.out + O_VS + (size_t)blk * TS * DM + h * 128, PAST / 64};
        att::attn_unit<float, 1>(Q + (size_t)(SEQ + 64 * blk) * DM + h * 128, kv, O + (size_t)(SEQ + 64 * blk) * DM + h * 128, 18,
                                 (const unsigned long long*)(P.ws + WS_MASKS) + (size_t)(64 * blk) * 18, 18, PAST, 64, -17, (LAS char*)lds, tid);
    }
}
#ifdef PROBE_ATT
constexpr int PR_NCHK = 96;
#ifndef PROBE_SHIFT
#define PROBE_SHIFT 0
#endif
__device__ __forceinline__ int probe_row(int i) { return i < 80 ? (i < 78 ? 200 + 207 * i : (i == 78 ? SEQ - 1 : SEQ - 70)) : SEQ + (i == 80 ? 0 : (i == 81 ? 63 : (i == 82 ? 2047 : 131 * (i - 82)))); }
__device__ __forceinline__ void probe_phase(const Params& P, LAS unsigned char* lds) {
    const int tid = threadIdx.x, lane = tid & 63;
    LAS float* qf = (LAS float*)lds;
    LAS float* red = (LAS float*)(lds + 8192);
    LAS int* sel = (LAS int*)(lds + 16384);
    LAS float* lg = (LAS float*)(lds + 20480);
    LAS float* qv = (LAS float*)(lds + 40960);
    unsigned* errw = (unsigned*)(P.ws + WS_CTL + 32768);
    float* scr = (float*)(P.ws + WS_WIN);
    for (int it = blockIdx.x; it < PR_NCHK; it += gridDim.x) {
        const int m = probe_row(it); const bool isP = m < SEQ; const int b = (m - SEQ) >> 6, t = (m - SEQ) & 63;
        const int n = isP ? 64 * (m / 64 + 1) : LS; const int qpos = isP ? m : PAST + t;
        const bf16_t* KI = isP ? (const bf16_t*)(P.ws + WS_KIP) : (const bf16_t*)(P.ws + WS_KIS) + (size_t)b * LS * 64;
        const unsigned* MK = isP ? (const unsigned*)(P.ws + WS_MASKP) + (size_t)m * 512 : (const unsigned*)(P.ws + WS_MASKS) + (size_t)(m - SEQ) * 36;
        float* sc = scr + (size_t)blockIdx.x * 16384;
        __syncthreads();
        for (int i = tid; i < 1024; i += NTHREADS) qf[i] = bf2f(((const bf16_t*)(P.ws + WS_QI))[(size_t)m * 1024 + i]);
        for (int i = tid; i < 2048; i += NTHREADS) qv[i] = bf2f(((const bf16_t*)(P.ws + WS_Q))[(size_t)m * DM + i]);
        __syncthreads();
        const float* WI = (const float*)(P.ws + WS_WI) + (size_t)m * 16;
        for (int k = tid; k < n; k += NTHREADS) {
            float s = 0.f;
            for (int h = 0; h < 16; ++h) { float d = 0.f; for (int e = 0; e < 64; ++e) d = fmaf(qf[h * 64 + e], bf2f(KI[(size_t)k * 64 + e]), d); s = fmaf(fmaxf(d, 0.f), WI[h], s); }
            sc[k] = s;
        }
        __syncthreads();
        int pop = 0; float mnsel = 3e38f, mxuns = -3e38f, amax = 0.f;
        for (int k = tid; k < n; k += NTHREADS) { const bool s = (MK[k >> 5] >> (k & 31)) & 1u; const float v = sc[k]; pop += s ? 1 : 0; if (s) mnsel = fminf(mnsel, v); else mxuns = fmaxf(mxuns, v); amax = fmaxf(amax, fabsf(v)); }
        for (int off = 32; off; off >>= 1) { pop += __shfl_xor(pop, off); mnsel = fminf(mnsel, __shfl_xor(mnsel, off)); mxuns = fmaxf(mxuns, __shfl_xor(mxuns, off)); amax = fmaxf(amax, __shfl_xor(amax, off)); }
        if (lane == 0) { red[(tid >> 6) * 4 + 0] = (float)pop; red[(tid >> 6) * 4 + 1] = mnsel; red[(tid >> 6) * 4 + 2] = mxuns; red[(tid >> 6) * 4 + 3] = amax; }
        __syncthreads();
        if (tid == 0) {
            float p = 0.f, a = 3e38f, c = -3e38f, d = 0.f;
            for (int w = 0; w < 8; ++w) { p += red[w * 4]; a = fminf(a, red[w * 4 + 1]); c = fmaxf(c, red[w * 4 + 2]); d = fmaxf(d, red[w * 4 + 3]); }
            const float e1 = fabsf(p - (float)(n < 256 ? n : 256));
            const float e2 = (n > 256 && c > -1e38f) ? fmaxf(c - a, 0.f) / (d + 1e-20f) : 0.f;
            atomicMax(errw + 0, __float_as_uint(e1)); atomicMax(errw + 1, __float_as_uint(e2));
            int cnt = 0;
            for (int k = 0; k < n && cnt < 320; ++k) if ((MK[k >> 5] >> (k & 31)) & 1u) sel[cnt++] = k;
            sel[320] = cnt;
        }
        __syncthreads();
        const int ns = sel[320];
        const int h = tid >> 5, l32 = tid & 31;
        float mx = -3e38f;
        for (int j = l32; j < ns; j += 32) {
            const int k = sel[j]; float d = 0.f;
            for (int e = 0; e < 128; ++e) {
                float kv;
                if (isP) kv = bf2f(((const bf16_t*)(P.ws + WS_KP))[(size_t)k * DM + h * 128 + e]);
                else kv = k < PAST ? P.in[4][((size_t)b * PAST + k) * DM + h * 128 + e] : P.out[O_KS + ((size_t)b * TS + (k - PAST)) * DM + h * 128 + e];
                d = fmaf(qv[h * 128 + e], isP ? kv : bf2f(f2bf(kv)), d);
            }
            const float lgt = d * 0.08838834764831845f + P.in[10][t5_bucket(k - qpos + PROBE_SHIFT) * 16 + h];
            lg[h * 256 + j] = lgt; mx = fmaxf(mx, lgt);
        }
        for (int off = 16; off; off >>= 1) mx = fmaxf(mx, __shfl_xor(mx, off));
        float sum = 0.f;
        for (int j = l32; j < ns; j += 32) { const float p = expf(lg[h * 256 + j] - mx); lg[h * 256 + j] = p; sum += p; }
        for (int off = 16; off; off >>= 1) sum += __shfl_xor(sum, off);
        __syncthreads();
        float o[4] = {0.f, 0.f, 0.f, 0.f};
        for (int j = 0; j < ns; ++j) {
            const int k = sel[j]; const float p = bf2f(f2bf(lg[h * 256 + j]));
#pragma unroll
            for (int c = 0; c < 4; ++c) {
                const int e = l32 * 4 + c; float vv;
                if (isP) vv = bf2f(((const bf16_t*)(P.ws + WS_VP))[(size_t)k * DM + h * 128 + e]);
                else vv = bf2f(f2bf(k < PAST ? P.in[5][((size_t)b * PAST + k) * DM + h * 128 + e] : P.out[O_VS + ((size_t)b * TS + (k - PAST)) * DM + h * 128 + e]));
                o[c] = fmaf(p, vv, o[c]);
            }
        }
        float ss = 0.f, dd = 0.f;
#pragma unroll
        for (int c = 0; c < 4; ++c) { const float r = o[c] / sum; const float f = bf2f(((const bf16_t*)(P.ws + WS_H))[(size_t)m * DM + h * 128 + l32 * 4 + c]); ss += r * r; dd += (r - f) * (r - f); }
        for (int off = 16; off; off >>= 1) { ss += __shfl_xor(ss, off); dd += __shfl_xor(dd, off); }
        if (l32 == 0) atomicMax(errw + 2, __float_as_uint(sqrtf(dd / (ss + 1e-30f))));
    }
}

__device__ __forceinline__ void probe_delta(const Params& P, LAS unsigned char* lds) {
    const int tid = threadIdx.x;
    LAS float* S = (LAS float*)lds;
    LAS float* qv = (LAS float*)(lds + 65536);
    LAS float* kv = qv + 128; LAS float* vv = qv + 256; LAS float* kS = qv + 384; LAS float* sc = qv + 512;
    LAS float* red = qv + 640;
    unsigned* errw = (unsigned*)(P.ws + WS_CTL + 32768);
    const bf16_t* QKVB = (const bf16_t*)(P.ws + WS_QKVB);
    const bf16_t* OBp = (const bf16_t*)(P.ws + WS_OB);
    for (int it = blockIdx.x; it < 64; it += gridDim.x) {
        const int b = (it * 7) & 31, h = it & 15;
        __syncthreads();
        for (int i = tid; i < 16384; i += NTHREADS) S[i] = P.in[8][((size_t)b * 16 + h) * 16384 + i];
        float dd = 0.f, ss = 0.f;
        for (int t = 0; t < 64; ++t) {
            const int m = SEQ + 64 * b + t;
            __syncthreads();
            if (tid < 384) {
                const int which = tid >> 7, c = tid & 127, col = which * 2048 + h * 128 + c;
                float acc = 0.f;
                for (int i = 0; i < 4; ++i) {
                    const int tt = t - 3 + i;
                    const float x = tt >= 0 ? bf2f(QKVB[(size_t)(SEQ + 64 * b + tt) * CONVB + col]) : P.in[7][((size_t)b * 3 + (3 + tt)) * CONVB + col];
                    acc = fmaf(P.in[16][(size_t)i * CONVB + col], x, acc);
                }
                qv[tid] = acc / (1.0f + expf(-acc));
            }
            if (tid == 384) {
                const float ab = ((const float*)(P.ws + WS_AB))[(size_t)m * 16 + h], bb = ((const float*)(P.ws + WS_BB))[(size_t)m * 16 + h];
                const float x = ab + P.in[18][h];
                sc[0] = expf(-expf(P.in[17][h]) * (x > 20.f ? x : log1pf(expf(x)))); sc[1] = 1.0f / (1.0f + expf(-bb));
            }
            __syncthreads();
            if (tid < 128) {
                float sq = 0.f, sk = 0.f; for (int i = 0; i < 128; ++i) { sq += qv[i] * qv[i]; sk += kv[i] * kv[i]; }
                sc[2] = rsqrtf(sq + 1e-6f) * 0.08838834764831845f; sc[3] = rsqrtf(sk + 1e-6f);
            }
            __syncthreads();
            if (tid < 128) { float a = 0.f; for (int i = 0; i < 128; ++i) a = fmaf(kv[i] * sc[3], S[i * 128 + tid], a); kS[tid] = a; }
            __syncthreads();
            { const float eg = sc[0], be = sc[1];
              for (int e = tid; e < 16384; e += NTHREADS) { const int i = e >> 7, j = e & 127; const float ki = kv[i] * sc[3]; S[e] = eg * (S[e] - be * ki * kS[j]) + be * ki * vv[j]; } }
            __syncthreads();
            if (tid < 128) {
                float o = 0.f; for (int i = 0; i < 128; ++i) o = fmaf(S[i * 128 + tid], qv[i] * sc[2], o);
                const float f = bf2f(OBp[(size_t)m * DM + h * 128 + tid]);
                dd += (o - f) * (o - f); ss += o * o;
            }
        }
        for (int off = 32; off; off >>= 1) { dd += __shfl_xor(dd, off); ss += __shfl_xor(ss, off); }
        if ((tid & 63) == 0 && tid < 128) { red[(tid >> 6) * 2] = dd; red[(tid >> 6) * 2 + 1] = ss; }
        __syncthreads();
        if (tid == 0) atomicMax(errw + 3, __float_as_uint(sqrtf((red[0] + red[2]) / (red[1] + red[3] + 1e-30f))));
    }
}
__device__ __forceinline__ void probe_report(const Params& P) {
    const unsigned* errw = (const unsigned*)(P.ws + WS_CTL + 32768);
    const float e = __uint_as_float(errw[PROBE_ATT - 1]);
    const float f = 1.0f + fminf(PROBE_GAIN * e, 1e6f);
    for (int i = blockIdx.x * NTHREADS + threadIdx.x; i < NB * TS * 64; i += gridDim.x * NTHREADS) P.out[O_KIS + i] *= f;
}
#endif
#ifndef MK_MODE
#define MK_MODE 2
#endif
constexpr int NPHASE = 14;
template <int LO, int HI> __global__ void __launch_bounds__(NTHREADS, 2) hybrid_fwd(const Params PK) {
    const Params& P = PK;
    extern __shared__ __attribute__((aligned(16))) unsigned char lds_raw[];
    LAS unsigned char* lds = (LAS unsigned char*)lds_raw;
    volatile LAS unsigned* st = (volatile LAS unsigned*)(lds + MISC_OFF);
    if (threadIdx.x == 0) { st[0] = 0u; st[1] = 0u; st[2] = 0u; st[3] = 0u; }
    __syncthreads();
    if (HI - LO > 1) (void)xcd_barrier_post((unsigned*)(PK.ws + WS_CTL) + PK.ph_lo * XCD_BAR_WORDS, st);
#define IN(k) (LO <= (k) && (k) < HI)
#ifndef MK_DOUBLE
#define MK_DOUBLE -1
#endif
#define PHASE(k) if (IN(k)) for (int rep_ = 0; rep_ < ((k) == MK_DOUBLE ? 2 : 1); ++rep_)
#define SEAM(k) do { if (IN(k) && IN((k) + 1)) { XcdBarrier b_; b_.bar = (unsigned*)(PK.ws + WS_CTL) + PK.ph_lo * XCD_BAR_WORDS; b_.x = xb_xcc_id(); b_.st = (volatile LAS unsigned*)(lds + MISC_OFF); xcd_barrier(b_); } } while (0)
    PHASE(0) {
        adaln_phase(P, lds);
        xpose_phase(P, lds);
        const float* ck = P.in[6]; bf16_t* KIS = (bf16_t*)(P.ws + WS_KIS);
        for (int t = blockIdx.x * NTHREADS + threadIdx.x; t < NB * PAST * 8; t += gridDim.x * NTHREADS) {
            const int b = t >> 13, rem = t & 8191;
            const f32x4 a = *(const f32x4*)(ck + (size_t)t * 8), c = *(const f32x4*)(ck + (size_t)t * 8 + 4);
            u32x4 o; o.x = cvt_pk_bf16(a[0], a[1]); o.y = cvt_pk_bf16(a[2], a[3]); o.z = cvt_pk_bf16(c[0], c[1]); o.w = cvt_pk_bf16(c[2], c[3]);
            *(u32x4*)(KIS + (size_t)b * LS * 64 + (size_t)rem * 8) = o;
        }
    }
    SEAM(0);
    PHASE(1) normmod_phase<0>(P);
    SEAM(1);
    PHASE(2) {
        pg8::Gemm g{(const bf16_t*)(P.ws + WS_H), (const bf16_t*)(P.ws + WS_WIN), MT, NPAD, DM}; pg8::StaticOrder S; S.init(MT, NPAD, (int)gridDim.x, (int)blockIdx.x);
        pg8::EpiIn E{P.out, P.ws};
        pg8::gemm_phase<pg8::EpiIn, pg8::StaticOrder>(lds, g, S, E, nullptr);
        xpose_tail_inproj(P, lds);
    }
    SEAM(2);
    PHASE(3) d1_phase(P, lds);
    SEAM(3);
    PHASE(4) d2_phase(P, lds);
    PHASE(5) indexer_phase(P, lds);
    SEAM(5);
#if defined(PROBE_ATT) && PROBE_ATT == 4
    probe_delta(P, lds);
    { XcdBarrier b_; b_.bar = (unsigned*)(PK.ws + WS_CTL) + PK.ph_lo * XCD_BAR_WORDS; b_.x = xb_xcc_id(); b_.st = (volatile LAS unsigned*)(lds + MISC_OFF); xcd_barrier(b_); }
#endif
    PHASE(6) attn_phase(P, lds);
    SEAM(6);
#if defined(PROBE_ATT) && PROBE_ATT != 4
    probe_phase(P, lds);
    { XcdBarrier b_; b_.bar = (unsigned*)(PK.ws + WS_CTL) + PK.ph_lo * XCD_BAR_WORDS; b_.x = xb_xcc_id(); b_.st = (volatile LAS unsigned*)(lds + MISC_OFF); xcd_barrier(b_); }
#endif
    PHASE(7) merge_phase(P);
    SEAM(7);
    PHASE(8) {
        pg8::Gemm g{(const bf16_t*)(P.ws + WS_H), (const bf16_t*)(P.ws + WS_WOUT), MT, DM, DM}; pg8::SplitOrder S; S.init(MT, DM, (int)gridDim.x, (int)blockIdx.x);
        pg8::EpiRes<0> E{P.in[0], P.in[1], P.out, (const float*)(P.ws + WS_MOD)};
        pg8::gemm_phase<pg8::EpiRes<0>, pg8::SplitOrder>(lds, g, S, E, nullptr);
    }
    SEAM(8);
    PHASE(9) normmod_phase<1>(P);
    SEAM(9);
    PHASE(10) {
        pg8::Gemm g{(const bf16_t*)(P.ws + WS_H), (const bf16_t*)(P.ws + WS_WGU), MT, 2 * DFF, DM}; pg8::StaticOrder S; S.init(MT, 2 * DFF, (int)gridDim.x, (int)blockIdx.x);
        pg8::EpiGU E{P.out, P.ws, P.in[23], P.in[24], P.in[9]};
        pg8::gemm_phase<pg8::EpiGU, pg8::StaticOrder>(lds, g, S, E, nullptr);
        xpose_tail_gateup(P, lds);
    }
    SEAM(10);
    PHASE(11) ffn_seam_phase(P);
    SEAM(11);
    PHASE(12) {
        pg8::Gemm g{(const bf16_t*)(P.ws + WS_UP), (const bf16_t*)(P.ws + WS_WDN), MT, DM, DFF}; pg8::SplitOrder S; S.init(MT, DM, (int)gridDim.x, (int)blockIdx.x);
        pg8::EpiRes<1> E{P.in[0], P.in[1], P.out, (const float*)(P.ws + WS_MOD)};
        pg8::gemm_phase<pg8::EpiRes<1>, pg8::SplitOrder>(lds, g, S, E, nullptr);
    }
    SEAM(12);
    PHASE(13) finalnorm_phase(P);
#ifdef PROBE_ATT
    { XcdBarrier b_; b_.bar = (unsigned*)(PK.ws + WS_CTL) + PK.ph_lo * XCD_BAR_WORDS; b_.x = xb_xcc_id(); b_.st = (volatile LAS unsigned*)(lds + MISC_OFF); xcd_barrier(b_); }
    probe_report(P);
#endif
#undef IN
#undef SEAM
}

extern "C" void kernel_launch(void* const* d_in, const int* in_sizes, int n_in, void* d_out, int out_size, void* d_ws, size_t ws_size, hipStream_t stream) {
    static int grid = 0;
    if (grid == 0) {
        if (n_in != 27 || out_size != (int)O_END || ws_size < WS_END) { fprintf(stderr, "kernel_launch: unexpected shapes (n_in %d, out %d, ws %zu, need %zu)\n", n_in, out_size, ws_size, (size_t)WS_END); grid = -1; return; }
        int dev = 0, cus = 0, per_cu = 0;
        if (hipGetDevice(&dev) != hipSuccess || hipDeviceGetAttribute(&cus, hipDeviceAttributeMultiprocessorCount, dev) != hipSuccess) { grid = -1; return; }
        hipError_t e = hipSuccess;
#define SETLDS(LO_, HI_) do { if (e == hipSuccess) e = hipFuncSetAttribute((const void*)(hybrid_fwd<LO_, HI_>), hipFuncAttributeMaxDynamicSharedMemorySize, LDS_BYTES); } while (0)
#if MK_MODE == 0
        SETLDS(0, 1); SETLDS(1, 2); SETLDS(2, 3); SETLDS(3, 4); SETLDS(4, 5); SETLDS(5, 6); SETLDS(6, 7); SETLDS(7, 8); SETLDS(8, 9); SETLDS(9, 10); SETLDS(10, 11); SETLDS(11, 12); SETLDS(12, 13); SETLDS(13, 14);
        const void* kq = (const void*)(hybrid_fwd<2, 3>);
#elif MK_MODE == 1
        SETLDS(0, 1); SETLDS(1, 14);
        const void* kq = (const void*)(hybrid_fwd<1, 14>);
#else
        SETLDS(0, 14);
        const void* kq = (const void*)(hybrid_fwd<0, 14>);
#endif
        if (e != hipSuccess) { fprintf(stderr, "kernel_launch: hipFuncSetAttribute failed\n"); grid = -1; return; }
        if (hipOccupancyMaxActiveBlocksPerMultiprocessor(&per_cu, kq, NTHREADS, LDS_BYTES) != hipSuccess || per_cu < 1) { fprintf(stderr, "kernel_launch: occupancy query says %d\n", per_cu); (void)hipGetLastError(); per_cu = 1; }
        grid = cus;
    }
    if (grid < 0) return;
    (void)hipMemsetAsync((char*)d_ws + WS_CTL, 0, 65536, stream);
    Params p{};
    for (int i = 0; i < 27; ++i) p.in[i] = (const float*)d_in[i];
    p.out = (float*)d_out; p.ws = (unsigned char*)d_ws;
#define LAUNCH(LO_, HI_, region) do { p.ph_lo = (region); p.ph_hi = (ws_size >= WS_END2) ? 1 : 0;     hipLaunchKernelGGL((hybrid_fwd<LO_, HI_>), dim3(grid), dim3(NTHREADS), LDS_BYTES, stream, p); } while (0)
#if MK_MODE == 0
    LAUNCH(0, 1, 0); LAUNCH(1, 2, 0); LAUNCH(2, 3, 0); LAUNCH(3, 4, 0); LAUNCH(4, 5, 0); LAUNCH(5, 6, 0); LAUNCH(6, 7, 0);
    LAUNCH(7, 8, 0); LAUNCH(8, 9, 0); LAUNCH(9, 10, 0); LAUNCH(10, 11, 0); LAUNCH(11, 12, 0); LAUNCH(12, 13, 0); LAUNCH(13, 14, 0);
#elif MK_MODE == 1
    LAUNCH(0, 1, 0); LAUNCH(1, 14, 1);
#else
    LAUNCH(0, 14, 0);
#endif
    const hipError_t le = hipPeekAtLastError();
    if (le != hipSuccess) fprintf(stderr, "kernel_launch: launch failed: %s\n", hipGetErrorName(le));
}
```
